# Optimizing an MI355X kernel written in HIP

```python
import math, functools
import jax, jax.numpy as jnp
from jax import lax
import numpy as np

D_MODEL = 1024
BATCH = 8
SEQ = 2048
DEPTH = 2
DEC_BATCH = 128
DEC_SEQ = 4
PAST_LEN = 16384
PAGE_SIZE = 128

POOL_WIDTH = D_MODEL // 2
POOL_WINDOWS = (2, 4, 8, 16)
N_POOL_GROUPS = len(POOL_WINDOWS)
POOL_GROUP = POOL_WIDTH // N_POOL_GROUPS
POOL_PAD = max(POOL_WINDOWS) - 1
N_HEADS = 8
N_KV_HEADS = 2
HEAD_DIM = 64
GQA_GROUP = N_HEADS // N_KV_HEADS
ATTN_WIDTH = N_HEADS * HEAD_DIM
WINDOW = 128
ATTN_BLOCK = 128
D_FF = 4 * D_MODEL
RMS_EPS = 1e-6
NEG_INF = -1e30
IN_SIZES = (POOL_WIDTH, ATTN_WIDTH, N_KV_HEADS * HEAD_DIM, N_KV_HEADS * HEAD_DIM, D_MODEL, D_MODEL)
IN_SPLITS = tuple(int(s) for s in np.cumsum(IN_SIZES)[:-1])
IN_WIDTH = int(sum(IN_SIZES))

kernel_name = "hybrid_pool_swa_gated_decoder_step"


def rms_norm(x, g):
    xf = x.astype(jnp.float32)
    y = xf * lax.rsqrt(jnp.mean(xf * xf, axis=-1, keepdims=True) + RMS_EPS)
    return (y * g.astype(jnp.float32)).astype(x.dtype)


def alibi_slopes():
    s = 2.0 ** (-8.0 * (np.arange(N_HEADS) + 1) / N_HEADS)
    return jnp.asarray(s, dtype=jnp.float32).reshape(N_KV_HEADS, GQA_GROUP)


def attend(q, k, v, dist, valid, sinks):
    scale = HEAD_DIM ** -0.5
    s = jnp.einsum('...qhgd,...khd->...hgqk', q, k, preferred_element_type=jnp.float32) * scale
    d = dist[..., None, None, :, :].astype(jnp.float32)
    s = s - alibi_slopes()[:, :, None, None] * d
    s = jnp.where(valid[..., None, None, :, :], s, NEG_INF)
    sink = sinks.astype(jnp.float32).reshape(N_KV_HEADS, GQA_GROUP)[:, :, None, None]
    m = jnp.maximum(jnp.max(s, axis=-1, keepdims=True), sink)
    p = jnp.exp(s - m)
    den = jnp.sum(p, axis=-1, keepdims=True) + jnp.exp(sink - m)
    return jnp.einsum('...hgqk,...khd->...qhgd', (p / den).astype(v.dtype), v)


def swa_prompt(q, k, v, sinks):
    B, T = q.shape[0], q.shape[1]
    nb = T // ATTN_BLOCK
    qb = q.reshape(B, nb, ATTN_BLOCK, N_KV_HEADS, GQA_GROUP, HEAD_DIM)
    kb = k.reshape(B, nb, ATTN_BLOCK, N_KV_HEADS, HEAD_DIM)
    vb = v.reshape(B, nb, ATTN_BLOCK, N_KV_HEADS, HEAD_DIM)
    kc = jnp.concatenate([jnp.concatenate([jnp.zeros_like(kb[:, :1]), kb[:, :-1]], axis=1), kb], axis=2)
    vc = jnp.concatenate([jnp.concatenate([jnp.zeros_like(vb[:, :1]), vb[:, :-1]], axis=1), vb], axis=2)
    blk = jnp.arange(nb)[:, None] * ATTN_BLOCK
    pos_q = blk + jnp.arange(ATTN_BLOCK)[None, :]
    pos_k = blk - ATTN_BLOCK + jnp.arange(2 * ATTN_BLOCK)[None, :]
    dist = pos_q[:, :, None] - pos_k[:, None, :]
    valid = (dist >= 0) & (dist < WINDOW) & (pos_k[:, None, :] >= 0)
    o = attend(qb, kc, vc, dist, valid, sinks)
    o = o.reshape(B, T, N_KV_HEADS, GQA_GROUP, HEAD_DIM)
    return o, k[:, -WINDOW:], v[:, -WINDOW:]


def swa_sample(q, k, v, sinks, cache_k, cache_v):
    Tn = q.shape[1]
    kc = jnp.concatenate([cache_k.astype(k.dtype), k], axis=1)
    vc = jnp.concatenate([cache_v.astype(v.dtype), v], axis=1)
    pos_q = jnp.arange(Tn)
    pos_k = jnp.arange(WINDOW + Tn) - WINDOW
    dist = pos_q[:, None] - pos_k[None, :]
    valid = (dist >= 0) & (dist < WINDOW)
    o = attend(q, kc, vc, dist, valid, sinks)
    return o, kc[:, -WINDOW:], vc[:, -WINDOW:]


def pool_mix(u, prefix, pos, w_pool, pool_scale):
    B, T, P = u.shape
    up = jnp.concatenate([prefix.astype(u.dtype), u], axis=1)
    upf = up.astype(jnp.float32)
    csum = jnp.concatenate([jnp.zeros((B, 1, P), jnp.float32), jnp.cumsum(upf, axis=1)], axis=1)
    uf = upf[:, POOL_PAD:]
    outs = []
    for g, w in enumerate(POOL_WINDOWS):
        lo, hi = g * POOL_GROUP, (g + 1) * POOL_GROUP
        wsum = csum[:, POOL_PAD + 1:POOL_PAD + 1 + T, lo:hi] - csum[:, POOL_PAD + 1 - w:POOL_PAD + 1 - w + T, lo:hi]
        cnt = jnp.minimum(w, pos + 1).astype(jnp.float32)[None, :, None]
        outs.append(wsum / cnt - uf[:, :, lo:hi])
    d = jnp.stack(outs, axis=2).astype(u.dtype)
    y = jnp.einsum('btgc,gcd->btgd', d, w_pool).reshape(B, T, P) * pool_scale
    return y, up[:, -POOL_PAD:]


def block(x, c, w_ada, b_ada, g1, w_in, w_pool, pool_scale, sinks, w_a, w_b, w_out,
          g2, w_up, w_down, pool_prefix, pos, attn_fn):
    B, T, _ = x.shape
    mod = (jax.nn.silu(c) @ w_ada + b_ada)[:, None, :]
    sh1, sc1, gt1, sh2, sc2, gt2 = jnp.split(mod, 6, axis=-1)
    h = rms_norm(x, g1) * (1 + sc1) + sh1
    z = h @ w_in
    u, q, k, v, ga, gb = jnp.split(z, IN_SPLITS, axis=-1)
    a, new_pool = pool_mix(u, pool_prefix, pos, w_pool, pool_scale)
    q = q.reshape(B, T, N_KV_HEADS, GQA_GROUP, HEAD_DIM)
    k = k.reshape(B, T, N_KV_HEADS, HEAD_DIM)
    v = v.reshape(B, T, N_KV_HEADS, HEAD_DIM)
    o, new_k, new_v = attn_fn(q, k, v, sinks)
    br_a = a @ w_a
    br_b = o.reshape(B, T, ATTN_WIDTH) @ w_b
    merged = jax.nn.sigmoid(ga) * br_a + jax.nn.sigmoid(gb) * br_b
    x = x + gt1 * (merged @ w_out)
    h2 = rms_norm(x, g2) * (1 + sc2) + sh2
    x = x + gt2 * (jnp.square(jax.nn.relu(h2 @ w_up)) @ w_down)
    return x, new_k, new_v, new_pool


def setup_inputs(seed: int = 0) -> dict:
    key = jax.random.key(seed)
    ks = jax.random.split(key, 24)
    f32 = jnp.float32
    nrm = lambda k, shape, s: jax.random.normal(k, shape, f32) * s
    return {
        "x_prompt": nrm(ks[0], (BATCH, SEQ, D_MODEL), 1.0),
        "x_sample": nrm(ks[1], (DEC_BATCH, DEC_SEQ, D_MODEL), 1.0),
        "cache_k": nrm(ks[2], (DEPTH, DEC_BATCH, WINDOW, N_KV_HEADS, HEAD_DIM), 1.0),
        "cache_v": nrm(ks[3], (DEPTH, DEC_BATCH, WINDOW, N_KV_HEADS, HEAD_DIM), 1.0),
        "state_pool": nrm(ks[4], (DEPTH, DEC_BATCH, POOL_PAD, POOL_WIDTH), 1.0),
        "c_prompt": nrm(ks[5], (BATCH, D_MODEL), 1.0),
        "c_sample": nrm(ks[6], (DEC_BATCH, D_MODEL), 1.0),
        "w_ada": nrm(ks[7], (DEPTH, D_MODEL, 6 * D_MODEL), 0.5 * D_MODEL ** -0.5),
        "b_ada": nrm(ks[8], (DEPTH, 6 * D_MODEL), 0.01),
        "norm1_g": 1.0 + nrm(ks[9], (DEPTH, D_MODEL), 0.05),
        "w_in": nrm(ks[10], (DEPTH, D_MODEL, IN_WIDTH), D_MODEL ** -0.5),
        "w_pool": nrm(ks[11], (DEPTH, N_POOL_GROUPS, POOL_GROUP, POOL_GROUP), POOL_GROUP ** -0.5),
        "pool_scale": 1.0 + nrm(ks[12], (DEPTH, POOL_WIDTH), 0.1),
        "attn_sinks": nrm(ks[13], (DEPTH, N_HEADS), 1.0),
        "w_a": nrm(ks[14], (DEPTH, POOL_WIDTH, D_MODEL), POOL_WIDTH ** -0.5),
        "w_b": nrm(ks[15], (DEPTH, ATTN_WIDTH, D_MODEL), ATTN_WIDTH ** -0.5),
        "w_out": nrm(ks[16], (DEPTH, D_MODEL, D_MODEL), D_MODEL ** -0.5),
        "norm2_g": 1.0 + nrm(ks[17], (DEPTH, D_MODEL), 0.05),
        "w_up": nrm(ks[18], (DEPTH, D_MODEL, D_FF), D_MODEL ** -0.5),
        "w_down": nrm(ks[19], (DEPTH, D_FF, D_MODEL), D_FF ** -0.5),
        "final_g": 1.0 + nrm(ks[20], (D_MODEL,), 0.05),
    }


def reference(x_prompt, x_sample, cache_k, cache_v, state_pool, c_prompt, c_sample,
              w_ada, b_ada, norm1_g, w_in, w_pool, pool_scale, attn_sinks, w_a, w_b,
              w_out, norm2_g, w_up, w_down, final_g):
    T, Tn = x_prompt.shape[1], x_sample.shape[1]
    pos_p = jnp.arange(T)
    pos_s = PAST_LEN + jnp.arange(Tn)
    xp, xs = x_prompt, x_sample
    kp_l, vp_l, pp_l, ks_l, vs_l, ps_l = [], [], [], [], [], []
    for l in range(DEPTH):
        lw = (w_ada[l], b_ada[l], norm1_g[l], w_in[l], w_pool[l], pool_scale[l], attn_sinks[l],
              w_a[l], w_b[l], w_out[l], norm2_g[l], w_up[l], w_down[l])
        prefix_p = jnp.zeros((xp.shape[0], POOL_PAD, POOL_WIDTH), xp.dtype)
        xp, kp, vp, pp = block(xp, c_prompt, *lw, prefix_p, pos_p, swa_prompt)
        attn_s = functools.partial(swa_sample, cache_k=cache_k[l], cache_v=cache_v[l])
        xs, k_s, v_s, p_s = block(xs, c_sample, *lw, state_pool[l], pos_s, attn_s)
        kp_l.append(kp); vp_l.append(vp); pp_l.append(pp)
        ks_l.append(k_s); vs_l.append(v_s); ps_l.append(p_s)
    y_prompt = rms_norm(xp, final_g)
    y_sample = rms_norm(xs, final_g)
    new_k_prompt = jnp.stack(kp_l, axis=0)
    new_v_prompt = jnp.stack(vp_l, axis=0)
    new_pool_prompt = jnp.stack(pp_l, axis=0)
    new_k_sample = jnp.stack(ks_l, axis=0)
    new_v_sample = jnp.stack(vs_l, axis=0)
    new_pool_sample = jnp.stack(ps_l, axis=0)
    return (y_prompt, y_sample, new_k_prompt, new_v_prompt, new_pool_prompt, new_k_sample, new_v_sample, new_pool_sample)
```

```cpp
#include <hip/hip_runtime.h>
#include <hip/hip_cooperative_groups.h>
#include <cstdio>
#include <cstdint>
namespace cg = cooperative_groups;

#ifndef MK_PER_PHASE
#define MK_PER_PHASE 0
#endif

#define LAS __attribute__((address_space(3)))
#define DI __device__ __forceinline__
typedef unsigned short bf16_t;
typedef short bf16x8 __attribute__((ext_vector_type(8)));
typedef short s16x4 __attribute__((ext_vector_type(4)));
typedef float f32x4 __attribute__((ext_vector_type(4)));
typedef float f32x2 __attribute__((ext_vector_type(2)));
typedef float f32x16 __attribute__((ext_vector_type(16)));
typedef unsigned u32x4 __attribute__((ext_vector_type(4)));
typedef unsigned u32x2 __attribute__((ext_vector_type(2)));

constexpr int DM = 1024, NB = 8, SEQ = 2048, DEPTH = 2, DB = 128, DS = 4, WIN = 128, PW = 512, PPAD = 15;
constexpr int MP = NB * SEQ;
constexpr int MS = DB * DS;
constexpr int M = MP + MS;
constexpr int NIN = 3328, DFF = 4096, NMOD = 6 * DM, NMODROWS = NB + DB;
constexpr int OFF_Y = 0;
constexpr int OFF_KP = M * DM;
constexpr int OFF_VP = OFF_KP + DEPTH * NB * WIN * 128;
constexpr int OFF_PP = OFF_VP + DEPTH * NB * WIN * 128;
constexpr int OFF_KS = OFF_PP + DEPTH * NB * PPAD * PW;
constexpr int OFF_VS = OFF_KS + DEPTH * DB * WIN * 128;
constexpr int OFF_PS = OFF_VS + DEPTH * DB * WIN * 128;
constexpr int OUT_TOTAL = OFF_PS + DEPTH * DB * PPAD * PW;
static_assert(OUT_TOTAL == 28303360, "d_out map");
constexpr size_t MiB = 1u << 20;
constexpr size_t WS_SC = 1 * MiB;
constexpr size_t WS_MOD = 2 * MiB;
constexpr size_t WS_W = 9 * MiB, WS_WL = 27 * MiB;
constexpr size_t W_IN = 0, W_PA = 13 * MiB / 2, W_B = 15 * MiB / 2, W_OUT = 17 * MiB / 2, W_UP = 21 * MiB / 2, W_DOWN = 37 * MiB / 2;
constexpr size_t WS_H = 63 * MiB;
constexpr size_t WS_Z = 96 * MiB;
constexpr size_t WS_U = WS_Z, WS_Q = WS_U + (size_t)M * 512 * 2, WS_K = WS_Q + (size_t)M * 512 * 2, WS_V = WS_K + (size_t)M * 128 * 2,
                 WS_GA = WS_V + (size_t)M * 128 * 2, WS_GB = WS_GA + (size_t)M * 1024 * 2, WS_D = WS_GB + (size_t)M * 1024 * 2,
                 WS_O = WS_D + (size_t)M * 512 * 2, WS_ZEND = WS_O + (size_t)M * 512 * 2;
constexpr size_t WS_FF = WS_Z;
constexpr size_t WS_WADA = WS_Z;
constexpr size_t WS_PB = 228 * MiB;
constexpr size_t WS_END = 244 * MiB;
static_assert(WS_PB + (size_t)8 * MS * DM * 4 <= WS_END && WS_FF + (size_t)M * DFF * 2 <= WS_PB && WS_ZEND <= WS_END && WS_FF + (size_t)M * DFF * 2 <= WS_END && W_DOWN + 8 * MiB <= WS_WL && WS_W + 2 * WS_WL <= WS_H && WS_H + (size_t)M * 2048 <= WS_Z, "ws map");

constexpr int LDS_BYTES = 147456;

DI int opaque_bid() { int b = blockIdx.x; asm volatile("" : "+s"(b)); return b; }
DI int opaque_tid() { int t = threadIdx.x; asm volatile("" : "+v"(t)); return t; }
typedef __bf16 bf16x2_t __attribute__((ext_vector_type(2)));
DI unsigned cvt_pk_bf16(float lo, float hi) { f32x2 v = {lo, hi}; bf16x2_t b = __builtin_convertvector(v, bf16x2_t); return __builtin_bit_cast(unsigned, b); }
DI float bf_lo(unsigned w) { return __uint_as_float(w << 16); }
DI float bf_hi(unsigned w) { return __uint_as_float(w & 0xffff0000u); }
DI float bf_f(bf16_t h) { return __uint_as_float(((unsigned)h) << 16); }
DI u32x4 pack8(f32x4 a, f32x4 b) { u32x4 w; w.x = cvt_pk_bf16(a[0], a[1]); w.y = cvt_pk_bf16(a[2], a[3]); w.z = cvt_pk_bf16(b[0], b[1]); w.w = cvt_pk_bf16(b[2], b[3]); return w; }
DI float sigmoidf_(float v) { return __builtin_amdgcn_rcpf(1.0f + __expf(-v)); }
DI int modrow(int row) { return row < MP ? (row >> 11) : NB + ((row - MP) >> 2); }
DI float shfl_xor_l(float v, int o, int lane) { return __builtin_bit_cast(float, __builtin_amdgcn_ds_bpermute((lane ^ o) << 2, __builtin_bit_cast(int, v))); }
DI float wave_sum(float v, int lane) {
#pragma unroll
    for (int o = 1; o < 64; o <<= 1) v += shfl_xor_l(v, o, lane);
    return v;
}
DI float wave_max(float v, int lane) {
#pragma unroll
    for (int o = 1; o < 64; o <<= 1) v = fmaxf(v, shfl_xor_l(v, o, lane));
    return v;
}

namespace pg8 {
constexpr int BM = 256, BK = 64, HALF = 128, HTB = HALF * BK * 2, STAGE_BYTES = 8 * HTB, NXCD = 8, WGM = 8;
__host__ __device__ __forceinline__ int lds_byte(int r, int c) { const int st = (r >> 4) * 2 + (c >> 5), rr = r & 15, cc = c & 31, ob = rr * 64 + cc * 2; return st * 1024 + (ob ^ (((ob >> 9) & 1) << 5)); }
__host__ __device__ __forceinline__ void stage_rc(int b, int& R, int& C) { const int st = b / 1024, sb = b % 1024, swz = sb ^ (((sb >> 9) & 1) << 5); R = (st >> 1) * 16 + swz / 64; C = (st & 1) * 32 + (swz % 64) / 2; }
__host__ __device__ __forceinline__ int perm32(int rho) { const int n = rho >> 4, i = rho & 15; return 8 * (i >> 2) + 4 * n + (i & 3); }

struct Unit { int pm, pn, ko; };
struct Gemm { const bf16_t* A; const bf16_t* Bt; int M, N, K, lda, ldb; };

struct StaticOrder {
    int nM, nN, nwg, G, c;
    __host__ __device__ void init(int M_, int N_, int G_, int c_) { nM = M_ / BM; nN = N_ / BM; nwg = nM * nN; G = G_; c = c_; }
    __host__ __device__ bool next(int i, Unit& u) const {
        const long L = (long)i * G + c; if (L >= nwg) return false;
        int wgid = (int)L; { const int q = nwg / NXCD, r = nwg % NXCD, xcd = wgid % NXCD, off = wgid / NXCD; wgid = (xcd < r ? xcd * (q + 1) : r * (q + 1) + (xcd - r) * q) + off; }
        const int nig = WGM * nN, gid = wgid / nig, fm = gid * WGM, gsz = (nM - fm) < WGM ? (nM - fm) : WGM;
        u.pm = fm + ((wgid % nig) % gsz); u.pn = (wgid % nig) / gsz; u.ko = 0; return true;
    }
};
struct SplitKOrder {
    int G, c, S, Kc;
    __host__ __device__ bool next(int i, Unit& u) const { const int L = i * G + c; if (L >= 8 * S) return false; const int tile = L & 7; u.pm = 64 + (tile >> 2); u.pn = tile & 3; u.ko = (L >> 3) * Kc; return true; }
};

template <class Epi, class Sched, bool ALIGN_EPI>
__device__ __forceinline__ void gemm_phase(LAS unsigned char* lds, const Gemm g, const Sched& S, const Epi& E) {
    const int tid = opaque_tid(), wid = __builtin_amdgcn_readfirstlane(tid >> 6), lane = tid & 63, wr = wid >> 2, wc = wid & 3, fr = lane & 15, fq = lane >> 4;
    const int K = g.K, nt = K / BK;
    unsigned voffA[2], voffB[2];
#pragma unroll
    for (int i = 0; i < 2; ++i) { int R, C; stage_rc(tid * 16 + i * 8192, R, C); const int Rb = Epi::PERM ? ((R & ~31) + perm32(R & 31)) : R;
        voffA[i] = (unsigned)(R * g.lda + C) * 2u; voffB[i] = (unsigned)(Rb * g.ldb + C) * 2u; }
    const size_t kstep = (size_t)(BK * 2);
    const size_t hA = (size_t)HALF * g.lda * 2, hB = (size_t)HALF * g.ldb * 2;
    const size_t tA = 2 * hA, tB = 2 * hB;
    const unsigned ldsw = (unsigned)wid * 1024u;
    const int aoff = lds_byte(wr * 64 + fr, fq * 8), boff = lds_byte(wc * 32 + fr, fq * 8);
#define PG8_SA(b, h) (((b) * 2 + (h)) * HTB)
#define PG8_SB(b, h) ((4 + (b) * 2 + (h)) * HTB)
#define PG8_STAGE(bufoff, gbase, voff) do { _Pragma("unroll") for (int _i = 0; _i < 2; ++_i) \
        __builtin_amdgcn_global_load_lds((const unsigned*)((const char*)(gbase) + (voff)[_i]), (LAS unsigned*)(lds + (bufoff) + ldsw + _i * 8192), 16, 0, 0); } while (0)
#define PG8_LDA(dst, b, h) do { _Pragma("unroll") for (int m = 0; m < 4; ++m) _Pragma("unroll") for (int k = 0; k < 2; ++k) dst[m][k] = *(const LAS bf16x8*)(lds + PG8_SA(b, h) + aoff + m * 2048 + k * 1024); } while (0)
#define PG8_LDB(dst, b, h) do { _Pragma("unroll") for (int n = 0; n < 2; ++n) _Pragma("unroll") for (int k = 0; k < 2; ++k) dst[n][k] = *(const LAS bf16x8*)(lds + PG8_SB(b, h) + boff + n * 2048 + k * 1024); } while (0)
#define PG8_MMA(ai, bj, At, Bt) do { __builtin_amdgcn_s_setprio(1); _Pragma("unroll") for (int m = 0; m < 4; ++m) _Pragma("unroll") for (int n = 0; n < 2; ++n) _Pragma("unroll") for (int k = 0; k < 2; ++k) \
        acc[ai][bj][m][n] = __builtin_amdgcn_mfma_f32_16x16x32_bf16(Bt[n][k], At[m][k], acc[ai][bj][m][n], 0, 0, 0); __builtin_amdgcn_s_setprio(0); } while (0)
#define PG8_WAIT_V(n) asm volatile("s_waitcnt vmcnt(" #n ")" ::: "memory")
#define PG8_WAIT_L(n) asm volatile("s_waitcnt lgkmcnt(" #n ")" ::: "memory")
#define PG8_BAR __builtin_amdgcn_s_barrier()
#define PG8_SCHED __builtin_amdgcn_sched_barrier(0)
    Unit cur, nxt; int ui = 0;
    if (!S.next(0, cur)) return;
    f32x4 acc[2][2][4][2];
#pragma unroll
    for (int a = 0; a < 2; ++a)
#pragma unroll
        for (int b = 0; b < 2; ++b)
#pragma unroll
            for (int m = 0; m < 4; ++m)
#pragma unroll
                for (int n = 0; n < 2; ++n) acc[a][b][m][n] = (f32x4){0.f, 0.f, 0.f, 0.f};
    bf16x8 At[4][2], B0[2][2], B1[2][2];
    const char* cA = (const char*)g.A + (size_t)cur.pm * tA + (size_t)cur.ko * 2; const char* cB = (const char*)g.Bt + (size_t)cur.pn * tB + (size_t)cur.ko * 2;
    PG8_STAGE(PG8_SB(0, 0), cB, voffB); PG8_STAGE(PG8_SB(0, 1), cB + hB, voffB); PG8_STAGE(PG8_SA(0, 0), cA, voffA); PG8_STAGE(PG8_SA(0, 1), cA + hA, voffA);
    if (wr == 1) PG8_BAR;
    PG8_WAIT_V(2); PG8_BAR;
    PG8_STAGE(PG8_SB(1, 0), cB + kstep, voffB); PG8_STAGE(PG8_SA(1, 0), cA + kstep, voffA); PG8_STAGE(PG8_SB(1, 1), cB + hB + kstep, voffB);
    PG8_WAIT_V(6); PG8_BAR;
    for (;;) {
        const bool has_next = S.next(ui + 1, nxt);
        const char* nA = has_next ? (const char*)g.A + (size_t)nxt.pm * tA + (size_t)nxt.ko * 2 : cA; const char* nB = has_next ? (const char*)g.Bt + (size_t)nxt.pn * tB + (size_t)nxt.ko * 2 : cB;
        for (int t = 0; t < nt; t += 2) {
            const bool last = (t == nt - 2);
            const char* a1 = cA + (size_t)(t + 1) * kstep;
            const char* a2 = last ? nA : cA + (size_t)(t + 2) * kstep; const char* b2 = last ? nB : cB + (size_t)(t + 2) * kstep;
            const char* a3 = a2 + kstep; const char* b3 = b2 + kstep;
            PG8_LDB(B0, 0, 0); PG8_LDB(B1, 0, 1); PG8_SCHED; PG8_LDA(At, 0, 0); PG8_STAGE(PG8_SA(1, 1), a1 + hA, voffA);
            PG8_WAIT_V(8); PG8_WAIT_L(0); PG8_BAR; PG8_MMA(0, 0, At, B0); PG8_MMA(0, 1, At, B1); PG8_BAR; PG8_SCHED;
            PG8_LDA(At, 0, 1); PG8_STAGE(PG8_SB(0, 0), b2, voffB); PG8_STAGE(PG8_SB(0, 1), b2 + hB, voffB); PG8_STAGE(PG8_SA(0, 0), a2, voffA);
            PG8_WAIT_V(8); PG8_WAIT_L(0); PG8_BAR; PG8_MMA(1, 0, At, B0); PG8_MMA(1, 1, At, B1); PG8_BAR; PG8_SCHED;
            PG8_LDB(B0, 1, 0); PG8_LDB(B1, 1, 1); PG8_SCHED; PG8_LDA(At, 1, 0); PG8_STAGE(PG8_SA(0, 1), a2 + hA, voffA);
            PG8_WAIT_V(8); PG8_WAIT_L(0); PG8_BAR; PG8_MMA(0, 0, At, B0); PG8_MMA(0, 1, At, B1); PG8_BAR; PG8_SCHED;
            PG8_LDA(At, 1, 1); PG8_STAGE(PG8_SB(1, 0), b3, voffB); PG8_STAGE(PG8_SB(1, 1), b3 + hB, voffB); PG8_STAGE(PG8_SA(1, 0), a3, voffA);
            PG8_WAIT_V(8); PG8_WAIT_L(0); PG8_BAR; PG8_MMA(1, 0, At, B0); PG8_MMA(1, 1, At, B1); PG8_BAR; PG8_SCHED;
        }
        if constexpr (ALIGN_EPI) { if (wr == 0) PG8_BAR; }
        E(acc, cur, wr, wc, fr, fq);
        if (!has_next) break;
#pragma unroll
        for (int a = 0; a < 2; ++a)
#pragma unroll
            for (int b = 0; b < 2; ++b)
#pragma unroll
                for (int m = 0; m < 4; ++m)
#pragma unroll
                    for (int n = 0; n < 2; ++n) acc[a][b][m][n] = (f32x4){0.f, 0.f, 0.f, 0.f};
        cur = nxt; cA = nA; cB = nB; ++ui;
        if constexpr (ALIGN_EPI) { if (wr == 1) PG8_BAR; }
    }
    PG8_WAIT_V(0);
    if constexpr (!ALIGN_EPI) { if (wr == 0) PG8_BAR; }
    PG8_BAR;
#undef PG8_SA
#undef PG8_SB
#undef PG8_STAGE
#undef PG8_LDA
#undef PG8_LDB
#undef PG8_MMA
#undef PG8_WAIT_V
#undef PG8_WAIT_L
#undef PG8_BAR
#undef PG8_SCHED
}
}
using pg8::Unit;

struct EpiAda {
    static constexpr bool PERM = false;
    float* mod; const float* bias;
    DI void operator()(const f32x4 (&acc)[2][2][4][2], const Unit& u, int wr, int wc, int fr, int fq) const {
#pragma unroll
        for (int ai = 0; ai < 2; ++ai)
#pragma unroll
            for (int m = 0; m < 4; ++m) { const int row = u.pm * 256 + ai * 128 + wr * 64 + m * 16 + fr;
                if (row < NMODROWS) {
#pragma unroll
                    for (int bj = 0; bj < 2; ++bj)
#pragma unroll
                        for (int n = 0; n < 2; ++n) { const int col = u.pn * 256 + bj * 128 + wc * 32 + n * 16 + fq * 4;
                            *(f32x4*)(mod + (size_t)row * (2 * NMOD) + col) = acc[ai][bj][m][n] + *(const f32x4*)(bias + col); } } }
    }
};
struct EpiIn {
    static constexpr bool PERM = true;
    bf16_t *U, *Q, *Kb, *Vb, *GA, *GB; float* out; int layer;
    DI void operator()(const f32x4 (&acc)[2][2][4][2], const Unit& u, int wr, int wc, int fr, int fq) const {
        const int pn = u.pn, cw = wc * 32 + 8 * fq;
#pragma unroll
        for (int ai = 0; ai < 2; ++ai)
#pragma unroll
            for (int m = 0; m < 4; ++m) { const int row = u.pm * 256 + ai * 128 + wr * 64 + m * 16 + fr;
#pragma unroll
                for (int bj = 0; bj < 2; ++bj) { f32x4 v0 = acc[ai][bj][m][0], v1 = acc[ai][bj][m][1]; const int c256 = bj * 128 + cw;
                    if (pn < 2) {
                        const int col = pn * 256 + c256;
                        *(u32x4*)(U + (size_t)row * 512 + col) = pack8(v0, v1);
                        float* po = nullptr;
                        { const int t = row & 2047; if (t >= SEQ - PPAD) po = out + OFF_PP + ((layer * NB + (row >> 11)) * PPAD + (t - (SEQ - PPAD))) * PW + col; }
                        if (po) { *(f32x4*)po = v0; *(f32x4*)(po + 4) = v1; }
                    } else if (pn < 4) {
                        const int col = (pn - 2) * 256 + c256;
                        *(u32x4*)(Q + (size_t)row * 512 + col) = pack8(v0 * 0.125f, v1 * 0.125f);
                    } else if (pn == 4) {
                        bf16_t* dst = bj == 0 ? Kb : Vb;
                        *(u32x4*)(dst + (size_t)row * 128 + cw) = pack8(v0, v1);
                        float* po = nullptr;
                        { const int t = row & 2047; if (t >= SEQ - WIN) po = out + (bj == 0 ? OFF_KP : OFF_VP) + ((layer * NB + (row >> 11)) * WIN + (t - (SEQ - WIN))) * 128 + cw; }
                        if (po) { *(f32x4*)po = v0; *(f32x4*)(po + 4) = v1; }
                    } else {
                        f32x4 s0, s1;
#pragma unroll
                        for (int e = 0; e < 4; ++e) { s0[e] = sigmoidf_(v0[e]); s1[e] = sigmoidf_(v1[e]); }
                        bf16_t* dst = pn < 9 ? GA + (pn - 5) * 256 : GB + (pn - 9) * 256;
                        *(u32x4*)(dst + (size_t)row * 1024 + c256) = pack8(s0, s1);
                    } } }
    }
};
template <int SECOND> struct EpiMix {
    static constexpr bool PERM = true;
    const bf16_t* G; bf16_t* MG;
    DI void operator()(const f32x4 (&acc)[2][2][4][2], const Unit& u, int wr, int wc, int fr, int fq) const {
        const unsigned col0 = (unsigned)(u.pn * 256 + wc * 32 + 8 * fq);
#pragma unroll
        for (int ai = 0; ai < 2; ++ai) {
            u32x4 gw[4][2], pw[4][2];
#pragma unroll
            for (int m = 0; m < 4; ++m)
#pragma unroll
                for (int bj = 0; bj < 2; ++bj) { const size_t off = (size_t)(u.pm * 256 + ai * 128 + wr * 64 + m * 16 + fr) * 1024 + col0 + bj * 128;
                    gw[m][bj] = *(const u32x4*)(G + off); if (SECOND) pw[m][bj] = *(const u32x4*)(MG + off); }
#pragma unroll
            for (int m = 0; m < 4; ++m)
#pragma unroll
                for (int bj = 0; bj < 2; ++bj) { const size_t off = (size_t)(u.pm * 256 + ai * 128 + wr * 64 + m * 16 + fr) * 1024 + col0 + bj * 128;
                    const u32x4 g4 = gw[m][bj]; f32x4 v0 = acc[ai][bj][m][0], v1 = acc[ai][bj][m][1];
                    v0[0] *= bf_lo(g4.x); v0[1] *= bf_hi(g4.x); v0[2] *= bf_lo(g4.y); v0[3] *= bf_hi(g4.y);
                    v1[0] *= bf_lo(g4.z); v1[1] *= bf_hi(g4.z); v1[2] *= bf_lo(g4.w); v1[3] *= bf_hi(g4.w);
                    if (SECOND) { const u32x4 p4 = pw[m][bj];
                        v0[0] += bf_lo(p4.x); v0[1] += bf_hi(p4.x); v0[2] += bf_lo(p4.y); v0[3] += bf_hi(p4.y);
                        v1[0] += bf_lo(p4.z); v1[1] += bf_hi(p4.z); v1[2] += bf_lo(p4.w); v1[3] += bf_hi(p4.w); }
                    *(u32x4*)(MG + off) = pack8(v0, v1); }
        }
    }
};
struct EpiRes {
    static constexpr bool PERM = false;
    const float *xp, *xs; const float* gate; float* X1; float gs;
    DI void operator()(const f32x4 (&acc)[2][2][4][2], const Unit& u, int wr, int wc, int fr, int fq) const {
        const unsigned colb = (unsigned)(u.pn * 256 + wc * 32 + fq * 4) * 4u;
        const char* gbase = (const char*)gate + (size_t)((u.pm * 256) >> 11) * (2 * NMOD) * 4;
        const char* xb = (const char*)xp; char* ob = (char*)X1;
#pragma unroll
        for (int ai = 0; ai < 2; ++ai)
#pragma unroll
            for (int m = 0; m < 4; ++m) { const unsigned rowb = (unsigned)(u.pm * 256 + ai * 128 + wr * 64 + m * 16 + fr) * (unsigned)(DM * 4);
                f32x4 xv[2][2], gv[2][2];
#pragma unroll
                for (int bj = 0; bj < 2; ++bj)
#pragma unroll
                    for (int n = 0; n < 2; ++n) { xv[bj][n] = *(const f32x4*)(xb + (rowb + colb + (unsigned)(bj * 128 + n * 16) * 4u)); gv[bj][n] = *(const f32x4*)(gbase + colb + (unsigned)(bj * 128 + n * 16) * 4u) * gs; }
#pragma unroll
                for (int bj = 0; bj < 2; ++bj)
#pragma unroll
                    for (int n = 0; n < 2; ++n) *(f32x4*)(ob + (rowb + colb + (unsigned)(bj * 128 + n * 16) * 4u)) = xv[bj][n] + gv[bj][n] * acc[ai][bj][m][n]; }
    }
};
struct EpiPartial {
    static constexpr bool PERM = false;
    float* PB; int Kc;
    DI void operator()(const f32x4 (&acc)[2][2][4][2], const Unit& u, int wr, int wc, int fr, int fq) const {
        float* pb = PB + (size_t)(u.ko / Kc) * MS * DM;
#pragma unroll
        for (int ai = 0; ai < 2; ++ai)
#pragma unroll
            for (int m = 0; m < 4; ++m) { const int r = u.pm * 256 + ai * 128 + wr * 64 + m * 16 + fr - MP;
#pragma unroll
                for (int bj = 0; bj < 2; ++bj)
#pragma unroll
                    for (int n = 0; n < 2; ++n) { const int col = u.pn * 256 + bj * 128 + wc * 32 + n * 16 + fq * 4;
                        *(f32x4*)(pb + (size_t)r * DM + col) = acc[ai][bj][m][n]; } }
    }
};
struct EpiUp {
    static constexpr bool PERM = true;
    bf16_t* FF;
    DI void operator()(const f32x4 (&acc)[2][2][4][2], const Unit& u, int wr, int wc, int fr, int fq) const {
        const __amdgpu_buffer_rsrc_t ffr = __builtin_amdgcn_make_buffer_rsrc(FF, 0, (int)((size_t)M * DFF * 2), 0x00020000);
#pragma unroll
        for (int ai = 0; ai < 2; ++ai)
#pragma unroll
            for (int m = 0; m < 4; ++m) { const int row = u.pm * 256 + ai * 128 + wr * 64 + m * 16 + fr;
#pragma unroll
                for (int bj = 0; bj < 2; ++bj) { const int col = u.pn * 256 + bj * 128 + wc * 32 + 8 * fq;
                    f32x4 v0 = acc[ai][bj][m][0], v1 = acc[ai][bj][m][1];
#pragma unroll
                    for (int e = 0; e < 4; ++e) { const float a = fmaxf(v0[e], 0.f), b = fmaxf(v1[e], 0.f); v0[e] = a * a; v1[e] = b * b; }
                    __builtin_amdgcn_raw_buffer_store_b128(pack8(v0, v1), ffr, (unsigned)(row * DFF + col) * 2u, 0,   0); } }
    }
};

struct Args { const float* in[21]; float* out; unsigned char* ws; int ph_lo, ph_hi; };

DI void transpose_item(const float* W, int K, int N, bf16_t* WT, int row_off, LAS float* scr, int item, int lane) {
    const int nblk = N / 32, kb = item / nblk, nb = item % nblk, k0 = 64 * kb, n0 = 32 * nb;
#pragma unroll 8
    for (int i = 0; i < 32; ++i) { const int kk = 2 * i + (lane >> 5); scr[kk * 33 + (lane & 31)] = W[(size_t)(k0 + kk) * N + n0 + (lane & 31)]; }
    asm volatile("s_waitcnt lgkmcnt(0)" ::: "memory");
    const int c = lane & 7;
#pragma unroll
    for (int j = 0; j < 4; ++j) { const int n = (lane >> 3) + 8 * j; const LAS float* s = scr + (8 * c) * 33 + n;
        u32x4 o; o.x = cvt_pk_bf16(s[0 * 33], s[1 * 33]); o.y = cvt_pk_bf16(s[2 * 33], s[3 * 33]); o.z = cvt_pk_bf16(s[4 * 33], s[5 * 33]); o.w = cvt_pk_bf16(s[6 * 33], s[7 * 33]);
        *(u32x4*)(WT + (size_t)(row_off + n0 + n) * K + k0 + 8 * c) = o; }
    asm volatile("s_waitcnt lgkmcnt(0)" ::: "memory");
}

DI void prologue(const Args& a, LAS unsigned char* lds, int G) {
    const int tid = opaque_tid(), lane = tid & 63, wave = tid >> 6;
    LAS float* scr = (LAS float*)(lds + wave * 16384);
    const int gw = opaque_bid() * 8 + wave, NGW = G * 8;
    unsigned char* ws = a.ws;
    constexpr int I_IN = (DM / 64) * (NIN / 32), I_B = (PW / 64) * (DM / 32), I_OUT = (DM / 64) * (DM / 32), I_UP = (DM / 64) * (DFF / 32), I_DOWN = (DFF / 64) * (DM / 32), I_ADA = (DM / 64) * (NMOD / 32);
    constexpr int I_LAYER = I_IN + I_B + I_OUT + I_UP + I_DOWN + I_ADA;
    for (int it = gw; it < 2 * I_LAYER; it += NGW) {
        const int l = it / I_LAYER; int r = it % I_LAYER;
        unsigned char* wl = ws + WS_W + (size_t)l * WS_WL;
        if (r < I_IN) { transpose_item(a.in[10] + (size_t)l * DM * NIN, DM, NIN, (bf16_t*)(wl + W_IN), 0, scr, r, lane); continue; } r -= I_IN;
        if (r < I_B) { transpose_item(a.in[15] + (size_t)l * PW * DM, PW, DM, (bf16_t*)(wl + W_B), 0, scr, r, lane); continue; } r -= I_B;
        if (r < I_OUT) { transpose_item(a.in[16] + (size_t)l * DM * DM, DM, DM, (bf16_t*)(wl + W_OUT), 0, scr, r, lane); continue; } r -= I_OUT;
        if (r < I_UP) { transpose_item(a.in[18] + (size_t)l * DM * DFF, DM, DFF, (bf16_t*)(wl + W_UP), 0, scr, r, lane); continue; } r -= I_UP;
        if (r < I_DOWN) { transpose_item(a.in[19] + (size_t)l * DFF * DM, DFF, DM, (bf16_t*)(wl + W_DOWN), 0, scr, r, lane); continue; } r -= I_DOWN;
        transpose_item(a.in[7] + (size_t)l * DM * NMOD, DM, NMOD, (bf16_t*)(ws + WS_WADA), l * NMOD, scr, r, lane);
    }
    const int gt = opaque_bid() * 512 + tid, NGT = G * 512;
    for (int it = gt; it < 2 * 65536; it += NGT) {
        const int l = it >> 16, rem = it & 65535, cgp = rem >> 10, n = rem & 1023, g = cgp >> 4, c0 = (cgp & 15) * 8;
        const float* wa = a.in[14] + (size_t)l * PW * DM + (size_t)(g * 128) * DM + n;
        const float* ps = a.in[12] + l * PW + g * 128;
        const float* wp = a.in[11] + ((size_t)(l * 4 + g) * 128 + c0) * 128;
        float acc[8];
#pragma unroll
        for (int j = 0; j < 8; ++j) acc[j] = 0.f;
#pragma unroll 16
        for (int d = 0; d < 128; ++d) { const float wv = wa[(size_t)d * DM] * ps[d];
#pragma unroll
            for (int j = 0; j < 8; ++j) acc[j] += wp[j * 128 + d] * wv; }
        u32x4 o; o.x = cvt_pk_bf16(acc[0], acc[1]); o.y = cvt_pk_bf16(acc[2], acc[3]); o.z = cvt_pk_bf16(acc[4], acc[5]); o.w = cvt_pk_bf16(acc[6], acc[7]);
        *(u32x4*)((bf16_t*)(ws + WS_W + (size_t)l * WS_WL + W_PA) + (size_t)n * PW + g * 128 + c0) = o;
    }
    for (int it = gt; it < 256 * DM / 2; it += NGT) {
        const int r = it >> 9, c2 = (it & 511) * 2; float v0 = 0.f, v1 = 0.f;
        if (r < NMODROWS) { const float* cp = r < NB ? a.in[5] + r * DM : a.in[6] + (r - NB) * DM; v0 = cp[c2]; v1 = cp[c2 + 1]; v0 = v0 * sigmoidf_(v0); v1 = v1 * sigmoidf_(v1); }
        ((unsigned*)(ws + WS_SC))[it] = cvt_pk_bf16(v0, v1);
    }
    for (int it = gt; it < MS * DM / 4; it += NGT) ((f32x4*)(a.out + OFF_Y + (size_t)MP * DM))[it] = ((const f32x4*)a.in[1])[it];
}

DI void rolling_copy(const Args& a, int l, int G) {
    const int gt = opaque_bid() * 512 + opaque_tid(), NGT = G * 512;
    constexpr int KV4 = (WIN - DS) * 128 / 4;
    for (int it = gt; it < DB * KV4; it += NGT) { const int lb = l * DB + it / KV4, e = it % KV4;
        ((f32x4*)(a.out + OFF_KS + (size_t)lb * WIN * 128))[e] = ((const f32x4*)(a.in[2] + (size_t)lb * WIN * 128 + DS * 128))[e];
        ((f32x4*)(a.out + OFF_VS + (size_t)lb * WIN * 128))[e] = ((const f32x4*)(a.in[3] + (size_t)lb * WIN * 128 + DS * 128))[e]; }
    constexpr int P4 = (PPAD - DS) * PW / 4;
    for (int it = gt; it < DB * P4; it += NGT) { const int lb = l * DB + it / P4, e = it % P4;
        ((f32x4*)(a.out + OFF_PS + (size_t)lb * PPAD * PW))[e] = ((const f32x4*)(a.in[4] + (size_t)lb * PPAD * PW + DS * PW))[e]; }
}

DI void norm_store_row(const f32x4 (&v)[4], float rstd, int row, int lane, const float* g, const float* mr, int sh_off, int sc_off, bf16_t* H) {
#pragma unroll
    for (int j = 0; j < 4; ++j) { const int c = lane * 4 + 256 * j;
        const f32x4 gg = *(const f32x4*)(g + c), sc = *(const f32x4*)(mr + sc_off + c), sh = *(const f32x4*)(mr + sh_off + c);
        const f32x4 h = v[j] * rstd * gg * (sc + 1.0f) + sh;
        u32x2 w; w.x = cvt_pk_bf16(h.x, h.y); w.y = cvt_pk_bf16(h.z, h.w);
        *(u32x2*)(H + (size_t)row * DM + c) = w; }
}
DI float norm_ss(const f32x4 (&v)[4]) { float s = 0.f;
#pragma unroll
    for (int j = 0; j < 4; ++j) s += (v[j].x * v[j].x + v[j].y * v[j].y) + (v[j].z * v[j].z + v[j].w * v[j].w);
    return s; }
DI void norm_phase(const float* xp, const float* xs, const float* g, const float* mod, int sh_off, int sc_off, bf16_t* H, int G, const float* pb, const float* pgate, float* xw) {
    const int tid_ = opaque_tid(), lane = tid_ & 63, gw = opaque_bid() * 8 + (tid_ >> 6), NGW = G * 8;
    if (gw < MP) {
        f32x4 cur[4], nxt[4];
#pragma unroll
        for (int j = 0; j < 4; ++j) cur[j] = *(const f32x4*)(xp + (size_t)gw * DM + lane * 4 + 256 * j);
        for (int row = gw; row < MP; row += NGW) {
            const int rn = row + NGW < MP ? row + NGW : row;
#pragma unroll
            for (int j = 0; j < 4; ++j) nxt[j] = *(const f32x4*)(xp + (size_t)rn * DM + lane * 4 + 256 * j);
            const float rstd = rsqrtf(wave_sum(norm_ss(cur), lane) * (1.f / DM) + 1e-6f);
            norm_store_row(cur, rstd, row, lane, g, mod + (size_t)(row >> 11) * (2 * NMOD), sh_off, sc_off, H);
#pragma unroll
            for (int j = 0; j < 4; ++j) cur[j] = nxt[j];
        }
    }
    for (int row = MP + gw; row < M; row += NGW) {
        const int r = row - MP; f32x4 v[4];
#pragma unroll
        for (int j = 0; j < 4; ++j) v[j] = *(const f32x4*)(xs + (size_t)r * DM + lane * 4 + 256 * j);
        if (pb) {
            const float* gr = pgate + (size_t)modrow(row) * (2 * NMOD);
#pragma unroll
            for (int j = 0; j < 4; ++j) { const int c = lane * 4 + 256 * j; f32x4 sum = {0.f, 0.f, 0.f, 0.f};
#pragma unroll
                for (int sk = 0; sk < 8; ++sk) sum += *(const f32x4*)(pb + ((size_t)sk * MS + r) * DM + c);
                v[j] += *(const f32x4*)(gr + c) * sum; *(f32x4*)(xw + (size_t)r * DM + c) = v[j]; }
        }
        const float rstd = rsqrtf(wave_sum(norm_ss(v), lane) * (1.f / DM) + 1e-6f);
        norm_store_row(v, rstd, row, lane, g, mod + (size_t)modrow(row) * (2 * NMOD), sh_off, sc_off, H);
    }
}
DI void final_norm_phase(float* X, const float* g, int G, const float* pb, const float* pgate) {
    const int tid_ = opaque_tid(), lane = tid_ & 63, gw = opaque_bid() * 8 + (tid_ >> 6), NGW = G * 8;
    if (gw < MP) {
        f32x4 cur[4], nxt[4];
#pragma unroll
        for (int j = 0; j < 4; ++j) cur[j] = *(const f32x4*)(X + (size_t)gw * DM + lane * 4 + 256 * j);
        for (int row = gw; row < MP; row += NGW) {
            const int rn = row + NGW < MP ? row + NGW : row;
#pragma unroll
            for (int j = 0; j < 4; ++j) nxt[j] = *(const f32x4*)(X + (size_t)rn * DM + lane * 4 + 256 * j);
            const float rstd = rsqrtf(wave_sum(norm_ss(cur), lane) * (1.f / DM) + 1e-6f);
#pragma unroll
            for (int j = 0; j < 4; ++j) { const int c = lane * 4 + 256 * j; *(f32x4*)(X + (size_t)row * DM + c) = cur[j] * rstd * *(const f32x4*)(g + c); }
#pragma unroll
            for (int j = 0; j < 4; ++j) cur[j] = nxt[j];
        }
    }
    for (int row = MP + gw; row < M; row += NGW) {
        const int r = row - MP; float* xr = X + (size_t)row * DM; const float* gr = pgate + (size_t)modrow(row) * (2 * NMOD);
        f32x4 v[4];
#pragma unroll
        for (int j = 0; j < 4; ++j) v[j] = *(const f32x4*)(xr + lane * 4 + 256 * j);
#pragma unroll
        for (int j = 0; j < 4; ++j) { const int c = lane * 4 + 256 * j; f32x4 sum = {0.f, 0.f, 0.f, 0.f};
#pragma unroll
            for (int sk = 0; sk < 8; ++sk) sum += *(const f32x4*)(pb + ((size_t)sk * MS + r) * DM + c);
            v[j] += *(const f32x4*)(gr + c) * sum; }
        const float rstd = rsqrtf(wave_sum(norm_ss(v), lane) * (1.f / DM) + 1e-6f);
#pragma unroll
        for (int j = 0; j < 4; ++j) { const int c = lane * 4 + 256 * j; *(f32x4*)(xr + c) = v[j] * rstd * *(const f32x4*)(g + c); }
    }
}

template <int R, bool SAMPLE>
DI void pool_rows(const bf16_t* Ub, bf16_t* Db, const float* prefix, int t0, int ch, int w) {
    f32x2 v[15 + R];
#pragma unroll
    for (int j = 0; j < 15 + R; ++j) { const int t = t0 - 15 + j;
        if (SAMPLE && j < 15) { v[j] = *(const f32x2*)(prefix + j * PW + ch); }
        else { const int tc = (SAMPLE || t >= 0) ? t : 0;
            unsigned wv = *(const unsigned*)(Ub + (size_t)tc * PW + ch); if (!SAMPLE && t < 0) wv = 0u; v[j].x = bf_lo(wv); v[j].y = bf_hi(wv); } }
    f32x2 s = {0.f, 0.f};
#pragma unroll
    for (int i = 1; i < 16; ++i) if (i < w) s += v[15 - i];
#pragma unroll
    for (int r = 0; r < R; ++r) { const f32x2 cur = v[15 + r]; s += cur;
        const int t = t0 + r; const float cnt = SAMPLE ? (float)w : (float)(w < t + 1 ? w : t + 1);
        const f32x2 d = s / cnt - cur;
        *(unsigned*)(Db + (size_t)t * PW + ch) = cvt_pk_bf16(d.x, d.y);
        const f32x2 sub = w == 2 ? v[15 + r - 1] : (w == 4 ? v[15 + r - 3] : (w == 8 ? v[15 + r - 7] : v[r]));
        s -= sub; }
}
DI void pool_phase(const bf16_t* U, bf16_t* D, const float* state_pool_l, int G) {
    const int tid = opaque_tid(), half = tid >> 8, ch = (tid & 255) * 2, g = ch >> 7, w = 2 << g;
    for (int item = opaque_bid(); item < 512 + 64; item += G) {
        if (item < 512) { const int b = item >> 6, t0 = (item & 63) * 32 + half * 16;
            pool_rows<16, false>(U + (size_t)b * SEQ * PW, D + (size_t)b * SEQ * PW, nullptr, t0, ch, w); }
        else { const int bs = (item - 512) * 2 + half;
            pool_rows<DS, true>(U + (size_t)(MP + bs * DS) * PW, D + (size_t)(MP + bs * DS) * PW, state_pool_l + (size_t)bs * PPAD * PW, 0, ch, w); }
    }
}

#define MFMA32(a, b, c) __builtin_amdgcn_mfma_f32_32x32x16_bf16((a), (b), (c), 0, 0, 0)
DI int crow(int reg, int h) { return (reg & 3) + 8 * (reg >> 2) + 4 * h; }
constexpr int KS_STRIDE = 72, VT_STRIDE = 260  , ATT_VT_OFF = 256 * KS_STRIDE * 2;
DI void attn_prompt_unit(LAS unsigned char* lds, const bf16_t* Q, const bf16_t* Kb, const bf16_t* Vb, bf16_t* O, const float* sinks, int unit) {
    const int tid = opaque_tid(), lane = tid & 63, wid = tid >> 6;
    const int b = unit >> 5, kvh = (unit >> 4) & 1, qblk = unit & 15;
    LAS bf16_t* Ks = (LAS bf16_t*)lds;
    LAS bf16_t* Vt = (LAS bf16_t*)(lds + ATT_VT_OFF);
    const int rowbase = b * SEQ + qblk * 128 - 128;
    __syncthreads();
#pragma unroll
    for (int i = 0; i < 4; ++i) {
        const int ch = tid + i * 512;
        { const int key = ch >> 3, c8 = ch & 7; u32x4 kv = {0u, 0u, 0u, 0u};
          if (qblk > 0 || key >= 128) kv = *(const u32x4*)(Kb + (size_t)(rowbase + key) * 128 + kvh * 64 + c8 * 8);
          *(LAS u32x4*)(Ks + key * KS_STRIDE + c8 * 8) = kv; }
        { const int key = ch & 255, c8 = ch >> 8; u32x4 vv = {0u, 0u, 0u, 0u};
          if (qblk > 0 || key >= 128) vv = *(const u32x4*)(Vb + (size_t)(rowbase + key) * 128 + kvh * 64 + c8 * 8);
          LAS bf16_t* vp = Vt + (c8 * 8) * VT_STRIDE + key;
          vp[0 * VT_STRIDE] = (bf16_t)(vv.x & 0xffffu); vp[1 * VT_STRIDE] = (bf16_t)(vv.x >> 16);
          vp[2 * VT_STRIDE] = (bf16_t)(vv.y & 0xffffu); vp[3 * VT_STRIDE] = (bf16_t)(vv.y >> 16);
          vp[4 * VT_STRIDE] = (bf16_t)(vv.z & 0xffffu); vp[5 * VT_STRIDE] = (bf16_t)(vv.z >> 16);
          vp[6 * VT_STRIDE] = (bf16_t)(vv.w & 0xffffu); vp[7 * VT_STRIDE] = (bf16_t)(vv.w >> 16); }
    }
    __syncthreads();
    const int qr = lane & 31, hl = lane >> 5;
#pragma unroll 1
    for (int it = 0; it < 2; ++it) {
        const int g = wid >> 1, sub = (wid & 1) * 2 + it, h = kvh * 4 + g, r0 = sub * 32;
        const float slope = exp2f(-(float)(h + 1)), sink = sinks[h];
        const size_t qrow = (size_t)(b * SEQ + qblk * 128 + r0 + qr);
        bf16x8 qf[4];
#pragma unroll
        for (int ks = 0; ks < 4; ++ks) qf[ks] = *(const bf16x8*)(Q + qrow * 512 + h * 64 + ks * 16 + hl * 8);
        f32x16 o[2];
#pragma unroll
        for (int e = 0; e < 16; ++e) { o[0][e] = 0.f; o[1][e] = 0.f; }
        float mrun = sink, lrun = hl == 0 ? 1.0f : 0.0f;
        const int dbase = 128 + qr - 4 * hl;
#pragma unroll 1
        for (int kt = 0; kt < 5; ++kt) {
            f32x16 st;
#pragma unroll
            for (int e = 0; e < 16; ++e) st[e] = 0.f;
#pragma unroll
            for (int ks = 0; ks < 4; ++ks) { const bf16x8 kf = *(const LAS bf16x8*)(Ks + (r0 + kt * 32 + qr) * KS_STRIDE + ks * 16 + hl * 8); st = MFMA32(kf, qf[ks], st); }
            const int dk = dbase - kt * 32, kmin = (qblk > 0) ? -1000 : 128 - r0 - kt * 32 - 4 * hl;
            float tm = -1e30f;
#pragma unroll
            for (int e = 0; e < 16; ++e) { const int ko = (e & 3) + 8 * (e >> 2); const int dist = dk - ko;
                const bool valid = ((unsigned)dist < (unsigned)WIN) && (ko >= kmin);
                const float v = valid ? st[e] - slope * (float)dist : -1e30f; st[e] = v; tm = fmaxf(tm, v); }
            tm = fmaxf(tm, shfl_xor_l(tm, 32, lane));
            const float mnew = fmaxf(mrun, tm), alpha = __expf(mrun - mnew);
            mrun = mnew; lrun *= alpha;
#pragma unroll
            for (int e = 0; e < 16; ++e) { o[0][e] *= alpha; o[1][e] *= alpha; }
            float ps = 0.f;
#pragma unroll
            for (int e = 0; e < 16; ++e) { const float p = __expf(st[e] - mnew); st[e] = p; ps += p; }
            lrun += ps;
#pragma unroll
            for (int s2 = 0; s2 < 2; ++s2) {
                u32x4 pw; pw.x = cvt_pk_bf16(st[8 * s2 + 0], st[8 * s2 + 1]); pw.y = cvt_pk_bf16(st[8 * s2 + 2], st[8 * s2 + 3]);
                pw.z = cvt_pk_bf16(st[8 * s2 + 4], st[8 * s2 + 5]); pw.w = cvt_pk_bf16(st[8 * s2 + 6], st[8 * s2 + 7]);
                const bf16x8 pf = __builtin_bit_cast(bf16x8, pw);
                const int kb = r0 + kt * 32 + 16 * s2 + 4 * hl;
#pragma unroll
                for (int dt = 0; dt < 2; ++dt) { const LAS bf16_t* vp = Vt + (dt * 32 + qr) * VT_STRIDE + kb;
                    const s16x4 lo = *(const LAS s16x4*)vp, hi = *(const LAS s16x4*)(vp + 8);
                    const bf16x8 vf = __builtin_shufflevector(lo, hi, 0, 1, 2, 3, 4, 5, 6, 7);
                    o[dt] = MFMA32(vf, pf, o[dt]); }
            }
        }
        lrun += shfl_xor_l(lrun, 32, lane);
        const float inv = 1.0f / lrun;
#pragma unroll
        for (int dt = 0; dt < 2; ++dt)
#pragma unroll
            for (int i4 = 0; i4 < 4; ++i4) { u32x2 w; w.x = cvt_pk_bf16(o[dt][4 * i4] * inv, o[dt][4 * i4 + 1] * inv); w.y = cvt_pk_bf16(o[dt][4 * i4 + 2] * inv, o[dt][4 * i4 + 3] * inv);
                *(u32x2*)(O + qrow * 512 + h * 64 + dt * 32 + 8 * i4 + 4 * hl) = w; }
    }
}
DI void attn_sample_pair(LAS unsigned char* wl, LAS unsigned char* wl_partner, int item, int part, const bf16_t* Q, const bf16_t* Kb, const bf16_t* Vb, bf16_t* O, const float* ck, const float* cv, const float* sinks) {
    const int lane = opaque_tid() & 63, b = item >> 3, h = item & 7, kvh = h >> 2;
    LAS float* qs = (LAS float*)wl;
    LAS float* sc = (LAS float*)(wl + 1024);
    LAS float* px = (LAS float*)(wl + 2304);
    const float slope = exp2f(-(float)(h + 1)), sink = sinks[h];
    const int row0 = MP + b * DS, j0 = part * 64;
    asm volatile("s_waitcnt lgkmcnt(0)" ::: "memory");
#pragma unroll
    for (int i = 0; i < DS; ++i) qs[i * 64 + lane] = bf_f(Q[(size_t)(row0 + i) * 512 + h * 64 + lane]);
    asm volatile("s_waitcnt lgkmcnt(0)" ::: "memory");
    {   const int j = j0 + lane; float a0 = 0.f, a1 = 0.f, a2 = 0.f, a3 = 0.f;
        const float* kr = ck + ((size_t)(b * WIN + j) * 2 + kvh) * 64;
#pragma unroll
        for (int d4 = 0; d4 < 16; ++d4) { const f32x4 kk = *(const f32x4*)(kr + d4 * 4);
            const f32x4 q0 = *(const LAS f32x4*)(qs + d4 * 4), q1 = *(const LAS f32x4*)(qs + 64 + d4 * 4), q2 = *(const LAS f32x4*)(qs + 128 + d4 * 4), q3 = *(const LAS f32x4*)(qs + 192 + d4 * 4);
            a0 += kk.x * q0.x + kk.y * q0.y + kk.z * q0.z + kk.w * q0.w; a1 += kk.x * q1.x + kk.y * q1.y + kk.z * q1.z + kk.w * q1.w;
            a2 += kk.x * q2.x + kk.y * q2.y + kk.z * q2.z + kk.w * q2.w; a3 += kk.x * q3.x + kk.y * q3.y + kk.z * q3.z + kk.w * q3.w; }
        const int d0 = WIN - j;
        sc[0 * 72 + lane] = (d0 + 0 >= 0 && d0 + 0 < WIN) ? a0 - slope * (float)(d0 + 0) : -1e30f;
        sc[1 * 72 + lane] = (d0 + 1 >= 0 && d0 + 1 < WIN) ? a1 - slope * (float)(d0 + 1) : -1e30f;
        sc[2 * 72 + lane] = (d0 + 2 >= 0 && d0 + 2 < WIN) ? a2 - slope * (float)(d0 + 2) : -1e30f;
        sc[3 * 72 + lane] = (d0 + 3 >= 0 && d0 + 3 < WIN) ? a3 - slope * (float)(d0 + 3) : -1e30f;
    }
    if (part == 1 && lane < DS) {
        float a0 = 0.f, a1 = 0.f, a2 = 0.f, a3 = 0.f;
        const bf16_t* kr = Kb + (size_t)(row0 + lane) * 128 + kvh * 64;
        u32x4 kw[8];
#pragma unroll
        for (int c8 = 0; c8 < 8; ++c8) kw[c8] = *(const u32x4*)(kr + c8 * 8);
#pragma unroll
        for (int c8 = 0; c8 < 8; ++c8) {
#pragma unroll
            for (int e = 0; e < 4; ++e) { const unsigned wv = kw[c8][e]; const float k0 = bf_lo(wv), k1 = bf_hi(wv); const int d = c8 * 8 + e * 2;
                a0 += k0 * qs[d] + k1 * qs[d + 1]; a1 += k0 * qs[64 + d] + k1 * qs[64 + d + 1]; a2 += k0 * qs[128 + d] + k1 * qs[128 + d + 1]; a3 += k0 * qs[192 + d] + k1 * qs[192 + d + 1]; } }
        const int d0 = -lane;
        sc[0 * 72 + 64 + lane] = (d0 + 0 >= 0) ? a0 - slope * (float)(d0 + 0) : -1e30f;
        sc[1 * 72 + 64 + lane] = (d0 + 1 >= 0) ? a1 - slope * (float)(d0 + 1) : -1e30f;
        sc[2 * 72 + 64 + lane] = (d0 + 2 >= 0) ? a2 - slope * (float)(d0 + 2) : -1e30f;
        sc[3 * 72 + 64 + lane] = (d0 + 3 >= 0) ? a3 - slope * (float)(d0 + 3) : -1e30f;
    }
    asm volatile("s_waitcnt lgkmcnt(0)" ::: "memory");
    const bool ext = (part == 1) && (lane < DS);
    float mloc[4], lloc[4];
#pragma unroll
    for (int i = 0; i < DS; ++i) {
        const float v0 = sc[i * 72 + lane], v1 = ext ? sc[i * 72 + 64 + lane] : -1e30f;
        const float mx = fmaxf(wave_max(fmaxf(v0, v1), lane), sink);
        const float p0 = __expf(v0 - mx), p1 = ext ? __expf(v1 - mx) : 0.f;
        sc[i * 72 + lane] = p0; if (ext) sc[i * 72 + 64 + lane] = p1;
        mloc[i] = mx; lloc[i] = wave_sum(p0 + p1, lane);
    }
    asm volatile("s_waitcnt lgkmcnt(0)" ::: "memory");
    float o0 = 0.f, o1 = 0.f, o2 = 0.f, o3 = 0.f;
#pragma unroll 32
    for (int jj = 0; jj < 64; ++jj) { const float vv = cv[((size_t)(b * WIN + j0 + jj) * 2 + kvh) * 64 + lane];
        o0 += sc[jj] * vv; o1 += sc[72 + jj] * vv; o2 += sc[144 + jj] * vv; o3 += sc[216 + jj] * vv; }
    if (part == 1) {
#pragma unroll
        for (int jj = 0; jj < DS; ++jj) { const float vv = bf_f(Vb[(size_t)(row0 + jj) * 128 + kvh * 64 + lane]);
            o0 += sc[64 + jj] * vv; o1 += sc[72 + 64 + jj] * vv; o2 += sc[144 + 64 + jj] * vv; o3 += sc[216 + 64 + jj] * vv; }
        if (lane < DS) { px[lane] = lane == 0 ? mloc[0] : (lane == 1 ? mloc[1] : (lane == 2 ? mloc[2] : mloc[3])); px[4 + lane] = lane == 0 ? lloc[0] : (lane == 1 ? lloc[1] : (lane == 2 ? lloc[2] : lloc[3])); }
        px[8 + lane] = o0; px[8 + 64 + lane] = o1; px[8 + 128 + lane] = o2; px[8 + 192 + lane] = o3;
    }
    __syncthreads();
    if (part == 0) {
        const LAS float* pp = (const LAS float*)(wl_partner + 2304);
        bf16_t* orow = O + (size_t)row0 * 512 + h * 64 + lane;
        const float oa[4] = {o0, o1, o2, o3};
#pragma unroll
        for (int i = 0; i < DS; ++i) { const float mb = pp[i], lb = pp[4 + i], ob = pp[8 + i * 64 + lane];
            const float mm = fmaxf(mloc[i], mb), ea = __expf(mloc[i] - mm), eb = __expf(mb - mm);
            const float den = lloc[i] * ea + lb * eb + __expf(sink - mm);
            orow[i * 512] = (bf16_t)(cvt_pk_bf16((oa[i] * ea + ob * eb) / den, 0.f) & 0xffffu); }
    }
    __syncthreads();
}

DI f32x4 small_tile(const bf16_t* A, int lda, const bf16_t* Bt, int ldb, int K, int row0, int col0, int lane) {
    const int fr = lane & 15, fq = lane >> 4;
    const bf16_t* ap = A + (size_t)(row0 + fr) * lda + fq * 8;
    const bf16_t* bp = Bt + (size_t)(col0 + fr) * ldb + fq * 8;
    f32x4 acc0 = {0.f, 0.f, 0.f, 0.f}, acc1 = {0.f, 0.f, 0.f, 0.f};
#pragma unroll 8
    for (int k = 0; k < K; k += 64) {
        const bf16x8 a0 = *(const bf16x8*)(ap + k), b0 = *(const bf16x8*)(bp + k), a1 = *(const bf16x8*)(ap + k + 32), b1 = *(const bf16x8*)(bp + k + 32);
        acc0 = __builtin_amdgcn_mfma_f32_16x16x32_bf16(b0, a0, acc0, 0, 0, 0);
        acc1 = __builtin_amdgcn_mfma_f32_16x16x32_bf16(b1, a1, acc1, 0, 0, 0);
    }
    return acc0 + acc1;
}
#define SMALL_LOOP(N_, first_) \
    const int tid_s = opaque_tid(), lane_s = tid_s & 63, w_s = tid_s >> 6, ncb_s = (N_) / 32, nblk_s = 8 * ncb_s, np_s = G - (first_); \
    if (opaque_bid() >= (first_)) for (int t_s = opaque_bid() - (first_); t_s < nblk_s; t_s += np_s)
#define SMALL_RC() const int row0 = (t_s / ncb_s) * 64 + (w_s >> 1) * 16, col0 = (t_s % ncb_s) * 32 + (w_s & 1) * 16, r = row0 + (lane_s & 15), col = col0 + 4 * (lane_s >> 4); (void)r; (void)col
DI void small_tile32(const bf16_t* A, int lda, const bf16_t* Bt, int ldb, int K, int row0, int col0, int lane, f32x4 (&acc)[2][2]) {
    const int fr = lane & 15, fq = lane >> 4;
    const bf16_t* ap = A + (size_t)(row0 + fr) * lda + fq * 8;
    const bf16_t* bp = Bt + (size_t)(col0 + fr) * ldb + fq * 8;
    const size_t a16 = (size_t)16 * lda, b16 = (size_t)16 * ldb;
#pragma unroll
    for (int i = 0; i < 2; ++i)
#pragma unroll
        for (int j = 0; j < 2; ++j) acc[i][j] = (f32x4){0.f, 0.f, 0.f, 0.f};
#pragma unroll 8
    for (int k = 0; k < K; k += 32) {
        const bf16x8 a0 = *(const bf16x8*)(ap + k), a1 = *(const bf16x8*)(ap + a16 + k), b0 = *(const bf16x8*)(bp + k), b1 = *(const bf16x8*)(bp + b16 + k);
        acc[0][0] = __builtin_amdgcn_mfma_f32_16x16x32_bf16(b0, a0, acc[0][0], 0, 0, 0);
        acc[0][1] = __builtin_amdgcn_mfma_f32_16x16x32_bf16(b1, a0, acc[0][1], 0, 0, 0);
        acc[1][0] = __builtin_amdgcn_mfma_f32_16x16x32_bf16(b0, a1, acc[1][0], 0, 0, 0);
        acc[1][1] = __builtin_amdgcn_mfma_f32_16x16x32_bf16(b1, a1, acc[1][1], 0, 0, 0);
    }
}
#define SMALL32_LOOP(N_, first_) \
    const int tid_s = opaque_tid(), lane_s = tid_s & 63, w_s = tid_s >> 6, ncb_s = (N_) / 64, nblk_s = 4 * ncb_s, np_s = G - (first_); \
    if (opaque_bid() >= (first_)) for (int t_s = opaque_bid() - (first_); t_s < nblk_s; t_s += np_s)
#define SMALL32_RC() const int row0 = (t_s / ncb_s) * 128 + (w_s >> 1) * 32, col0 = (t_s % ncb_s) * 64 + (w_s & 1) * 32
#define SMALL32_EACH() _Pragma("unroll") for (int i_s = 0; i_s < 2; ++i_s) _Pragma("unroll") for (int j_s = 0; j_s < 2; ++j_s)
#define SMALL32_ELEM() const int r = row0 + 16 * i_s + (lane_s & 15), col = col0 + 16 * j_s + 4 * (lane_s >> 4); const f32x4 v = acc_s[i_s][j_s]
DI u32x2 pack4(f32x4 v) { u32x2 w; w.x = cvt_pk_bf16(v[0], v[1]); w.y = cvt_pk_bf16(v[2], v[3]); return w; }

#define XB_TMO      128
#define XB_XCNT(j)  (256  + 64 * (j))
#define XB_XSUB(j)  (1280 + 64 * (j))
#define XB_XGEN(j)  (2304 + 64 * (j))
#define XB_TOP      3328
#define XB_TOPGEN   3392
#define XCD_BAR_WORDS 3456
#define XB_SPIN_CAP (1u << 18)

__device__ __forceinline__ unsigned xb_ld(unsigned* p)              { return __hip_atomic_load(p, __ATOMIC_RELAXED, __HIP_MEMORY_SCOPE_AGENT); }
__device__ __forceinline__ unsigned xb_add(unsigned* p, unsigned v) { return __hip_atomic_fetch_add(p, v, __ATOMIC_RELAXED, __HIP_MEMORY_SCOPE_AGENT); }
__device__ __forceinline__ unsigned xb_xcc_id() { return (unsigned)__builtin_amdgcn_s_getreg((3 << 11) | 20) & 0xFu; }
#define XB_SPIN(cond, bar) do { unsigned _sp = 0; while (cond) { __builtin_amdgcn_s_sleep(1); \
    if ((++_sp & 255u) == 0u) { if (xb_ld(&(bar)[XB_TMO])) break; if (_sp > XB_SPIN_CAP) { atomicAdd(&(bar)[XB_TMO], 1u); break; } } } } while (0)

struct XcdBarrier {
    unsigned* bar; unsigned x;
    volatile LAS unsigned* st;
};

__device__ __forceinline__ XcdBarrier xcd_barrier_post(unsigned* bar, volatile LAS unsigned* st) {
    XcdBarrier b; b.bar = bar; b.x = xb_xcc_id(); b.st = st;
    if (threadIdx.x == 0) (void)xb_add(&bar[XB_XCNT(b.x)], 1u);
    return b;
}
__device__ __forceinline__ void xcd_barrier_complete(unsigned* bar, unsigned x, unsigned& nloc, unsigned& nx) {
    const unsigned G = gridDim.x * gridDim.y * gridDim.z;
    unsigned sum, cnt, mine, sp = 0u;
    for (;;) {
        sum = 0u; cnt = 0u; mine = 0u;
#pragma unroll
        for (unsigned j = 0; j < 16; ++j) { const unsigned c = xb_ld(&bar[XB_XCNT(j)]); sum += c; cnt += (c > 0u) ? 1u : 0u; mine = (j == x) ? c : mine; }
        if (sum == G) break;
        __builtin_amdgcn_s_sleep(1);
        if ((++sp & 255u) == 0u) { if (xb_ld(&bar[XB_TMO])) break; if (sp > XB_SPIN_CAP) { atomicAdd(&bar[XB_TMO], 1u); break; } }
    }
    nloc = mine > 0u ? mine : 1u; nx = cnt > 0u ? cnt : 1u;
}

__device__ __forceinline__ void xcd_barrier(const XcdBarrier& b) {
    asm volatile("s_waitcnt vmcnt(0)" ::: "memory");
    __syncthreads();
    if (threadIdx.x == 0) {
        unsigned* bar = b.bar; asm volatile("" : "+s"(bar));
        __builtin_amdgcn_s_waitcnt(0);
        unsigned nloc = b.st[0], nx = b.st[1];
        if (nloc == 0u) { xcd_barrier_complete(bar, b.x, nloc, nx); b.st[0] = nloc; b.st[1] = nx; }
        const unsigned old = xb_add(&bar[XB_XSUB(b.x)], 1u);
        const unsigned gen = old / nloc;
        if (old + 1u == (gen + 1u) * nloc) {
            __builtin_amdgcn_fence(__ATOMIC_RELEASE, "agent");
            asm volatile("s_waitcnt vmcnt(0)" ::: "memory");
            const unsigned og = xb_add(&bar[XB_TOP], 1u);
            const unsigned tg = og / nx;
            if (og + 1u == (tg + 1u) * nx) xb_add(&bar[XB_TOPGEN], 1u);
            else XB_SPIN(xb_ld(&bar[XB_TOPGEN]) == tg, bar);
            __builtin_amdgcn_fence(__ATOMIC_ACQUIRE, "agent");
            xb_add(&bar[XB_XGEN(b.x)], 1u);
            asm volatile("s_waitcnt vmcnt(0)" ::: "memory");
        } else {
            XB_SPIN(xb_ld(&bar[XB_XGEN(b.x)]) == gen, bar);
            __builtin_amdgcn_fence(__ATOMIC_ACQUIRE, "agent");
            asm volatile("s_waitcnt vmcnt(0)" ::: "memory");
        }
    }
    __syncthreads();
}


__global__ void __launch_bounds__(512, 2) fwd_kernel(Args a) {
    extern __shared__ __attribute__((aligned(16))) unsigned char lds_raw[];
    LAS unsigned char* lds = (LAS unsigned char*)lds_raw;
    cg::grid_group grid = cg::this_grid();
    volatile LAS unsigned* xb_st = (volatile LAS unsigned*)(lds + LDS_BYTES - 64);
    if (threadIdx.x == 0) { xb_st[0] = 0u; xb_st[1] = 0u; }
    __syncthreads();
    XcdBarrier xbar = xcd_barrier_post((unsigned*)a.ws + 4096, xb_st);
    const int G = gridDim.x, lo = a.ph_lo, hi = a.ph_hi;
typedef __attribute__((address_space(1))) unsigned char gchar_t; typedef __attribute__((address_space(1))) float gfloat_t;
#define PHASE_BEGIN gchar_t* wsg_ = (gchar_t*)a.ws; gfloat_t* outg_ = (gfloat_t*)a.out; asm volatile("" : "+s"(wsg_), "+s"(outg_)); unsigned char* ws_ = (unsigned char*)wsg_; float* out_ = (float*)outg_;
#define X1 (out_ + OFF_Y)
#define mod ((float*)(ws_ + WS_MOD))
#define H ((bf16_t*)(ws_ + WS_H))
#define Ub ((bf16_t*)(ws_ + WS_U))
#define Qb ((bf16_t*)(ws_ + WS_Q))
#define Kb ((bf16_t*)(ws_ + WS_K))
#define Vb ((bf16_t*)(ws_ + WS_V))
#define GA ((bf16_t*)(ws_ + WS_GA))
#define GB ((bf16_t*)(ws_ + WS_GB))
#define Db ((bf16_t*)(ws_ + WS_D))
#define Ob ((bf16_t*)(ws_ + WS_O))
#define FF ((bf16_t*)(ws_ + WS_FF))
#define PB ((float*)(ws_ + WS_PB))
#define wl (ws_ + WS_W + (size_t)l * WS_WL)
#define modl (mod + l * NMOD)
#define xp (l == 0 ? a.in[0] : (const float*)X1)
#define xs (l == 0 ? a.in[1] : (const float*)(X1 + (size_t)MP * DM))
#ifndef PHASE_MASK
#define PHASE_MASK 0xffff
#endif
#ifndef MK_REPEAT_MASK
#define MK_REPEAT_MASK 0
#endif
#ifndef MK_MIX_SUB
#define MK_MIX_SUB 7
#endif
#ifndef MK_PROBE_OUT
#define MK_PROBE_OUT 0
#endif
#ifndef MK_PROBE_DOWN
#define MK_PROBE_DOWN 0
#endif
#ifndef MK_EXTRA_SYNCS
#define MK_EXTRA_SYNCS 0
#endif
#define REP(id) for (int rep_ = 0; rep_ < 1 + ((((MK_REPEAT_MASK) >> (id)) & 1)); ++rep_)
#define IN(k, id) ((((PHASE_MASK) >> (id)) & 1) && lo <= (k) && (k) < hi)
#define SEAM(k) do { if (lo <= (k) && (k) + 1 < hi) xcd_barrier(xbar); } while (0)

    if (a.ph_hi < 0) grid.sync();
    if (IN(0, 0)) { PHASE_BEGIN REP(0) prologue(a, lds, G); SEAM(0); for (int e_ = 0; e_ < MK_EXTRA_SYNCS; ++e_) xcd_barrier(xbar); }
    if (IN(1, 1)) { PHASE_BEGIN REP(1) {
        pg8::Gemm g{(const bf16_t*)(ws_ + WS_SC), (const bf16_t*)(ws_ + WS_WADA), 256, 2 * NMOD, DM, DM, DM};
        pg8::StaticOrder S; S.init(256, 2 * NMOD, G, opaque_bid());
        EpiAda E{mod, a.in[8]};
        pg8::gemm_phase<EpiAda, pg8::StaticOrder, true>(lds, g, S, E);
        }
        SEAM(1);
    }
#pragma unroll 1
    for (int l = 0; l < DEPTH; ++l) {
        const int pb = 2 + 8 * l;
        if (IN(pb + 0, 2)) { PHASE_BEGIN REP(2) norm_phase(xp, xs, a.in[9] + l * DM, modl, 0 * DM, 1 * DM, H, G, l == 0 ? nullptr : PB, mod + (l - 1) * NMOD + 5 * DM, X1 + (size_t)MP * DM); SEAM(pb + 0); }
        if (IN(pb + 1, 3)) { PHASE_BEGIN REP(3) {
            pg8::Gemm g{H, (const bf16_t*)(wl + W_IN), MP, NIN, DM, DM, DM};
            pg8::StaticOrder S; S.init(MP, NIN, G, opaque_bid());
            EpiIn E{Ub, Qb, Kb, Vb, GA, GB, a.out, l};
            pg8::gemm_phase<EpiIn, pg8::StaticOrder, true>(lds, g, S, E);
            {
                const int first = (G == 256) ? 64 : 0;
                SMALL32_LOOP(NIN, first) { SMALL32_RC(); f32x4 acc_s[2][2];
                    small_tile32(H + (size_t)MP * DM, DM, (const bf16_t*)(wl + W_IN), DM, DM, row0, col0, lane_s, acc_s);
                    SMALL32_EACH() { SMALL32_ELEM();
                    const size_t grow = (size_t)(MP + r);
                    if (col < 512) { *(u32x2*)(Ub + grow * 512 + col) = pack4(v);
                        *(f32x4*)(a.out + OFF_PS + ((l * DB + (r >> 2)) * PPAD + (PPAD - DS) + (r & 3)) * PW + col) = v; }
                    else if (col < 1024) { *(u32x2*)(Qb + grow * 512 + (col - 512)) = pack4(v * 0.125f); }
                    else if (col < 1152) { *(u32x2*)(Kb + grow * 128 + (col - 1024)) = pack4(v);
                        *(f32x4*)(a.out + OFF_KS + ((l * DB + (r >> 2)) * WIN + (WIN - DS) + (r & 3)) * 128 + (col - 1024)) = v; }
                    else if (col < 1280) { *(u32x2*)(Vb + grow * 128 + (col - 1152)) = pack4(v);
                        *(f32x4*)(a.out + OFF_VS + ((l * DB + (r >> 2)) * WIN + (WIN - DS) + (r & 3)) * 128 + (col - 1152)) = v; }
                    else { f32x4 sg; sg[0] = sigmoidf_(v[0]); sg[1] = sigmoidf_(v[1]); sg[2] = sigmoidf_(v[2]); sg[3] = sigmoidf_(v[3]);
                        bf16_t* dst = col < 2304 ? GA + (col - 1280) : GB + (col - 2304);
                        *(u32x2*)(dst + grow * 1024) = pack4(sg); } }
                }
            } }
            SEAM(pb + 1);
        }
        if (IN(pb + 2, 4)) { PHASE_BEGIN REP(4) {
            const float* sinks = a.in[13] + l * 8;
            rolling_copy(a, l, G);
            const bool last_rep_ = (rep_ == (((MK_REPEAT_MASK) >> 4) & 1));
            if (last_rep_ || (MK_MIX_SUB & 1))
            for (int u = opaque_bid(); u < 256; u += G) attn_prompt_unit(lds, Qb, Kb, Vb, Ob, sinks, u);
            if (last_rep_ || (MK_MIX_SUB & 2))
            { const int wave = opaque_tid() >> 6;
              for (int it = opaque_bid() * 4 + (wave & 3); it < DB * 8; it += G * 4)
                  attn_sample_pair(lds + 73728 + wave * 4096, lds + 73728 + (wave ^ 4) * 4096, it, wave >> 2, Qb, Kb, Vb, Ob, a.in[2] + (size_t)l * DB * WIN * 128, a.in[3] + (size_t)l * DB * WIN * 128, sinks); }
            if (last_rep_ || (MK_MIX_SUB & 4))
            pool_phase(Ub, Db, a.in[4] + (size_t)l * DB * PPAD * PW, G);
            }
            SEAM(pb + 2);
        }
        if (IN(pb + 3, 5)) { PHASE_BEGIN REP(5) {
            { pg8::Gemm g{Db, (const bf16_t*)(wl + W_PA), MP, DM, PW, PW, PW};
              pg8::StaticOrder S; S.init(MP, DM, G, opaque_bid());
              EpiMix<0> E{GA, H};
              pg8::gemm_phase<EpiMix<0>, pg8::StaticOrder, true>(lds, g, S, E); }
#ifndef MK_SKIP_MIX2
            { pg8::Gemm g{Ob, (const bf16_t*)(wl + W_B), MP, DM, PW, PW, PW};
              pg8::StaticOrder S; S.init(MP, DM, G, opaque_bid());
              EpiMix<1> E{GB, H};
              pg8::gemm_phase<EpiMix<1>, pg8::StaticOrder, true>(lds, g, S, E); }
#endif
            {   SMALL_LOOP(DM, 0) { SMALL_RC();
                    const f32x4 va = small_tile(Db + (size_t)MP * PW, PW, (const bf16_t*)(wl + W_PA), PW, PW, row0, col0, lane_s);
                    const f32x4 vb = small_tile(Ob + (size_t)MP * PW, PW, (const bf16_t*)(wl + W_B), PW, PW, row0, col0, lane_s);
                    const size_t off = (size_t)(MP + r) * 1024 + col;
                    const u32x2 ga = *(const u32x2*)(GA + off), gb = *(const u32x2*)(GB + off);
                    f32x4 mg; mg[0] = bf_lo(ga.x) * va[0] + bf_lo(gb.x) * vb[0]; mg[1] = bf_hi(ga.x) * va[1] + bf_hi(gb.x) * vb[1];
                    mg[2] = bf_lo(ga.y) * va[2] + bf_lo(gb.y) * vb[2]; mg[3] = bf_hi(ga.y) * va[3] + bf_hi(gb.y) * vb[3];
                    *(u32x2*)(H + off) = pack4(mg); }
            } }
            SEAM(pb + 3);
        }
        if (IN(pb + 4, 6)) { PHASE_BEGIN for (int rp_ = 0; rp_ < 1 + MK_PROBE_OUT; ++rp_) { const float gs = (rp_ == MK_PROBE_OUT) ? 1.f : 0.f;
            pg8::Gemm g{H, (const bf16_t*)(wl + W_OUT), MP, DM, DM, DM, DM};
            pg8::StaticOrder S; S.init(MP, DM, G, opaque_bid());
            EpiRes E{xp, xs, modl + 2 * DM, X1, gs};
            pg8::gemm_phase<EpiRes, pg8::StaticOrder, true>(lds, g, S, E);
            {
                int kc = 128; asm volatile("" : "+s"(kc));
                pg8::Gemm g2{H, (const bf16_t*)(wl + W_OUT), M, DM, kc, DM, DM};
                pg8::SplitKOrder S2{G, opaque_bid(), 8, kc};
                EpiPartial E2{PB, kc};
                pg8::gemm_phase<EpiPartial, pg8::SplitKOrder, true>(lds, g2, S2, E2);
            } }
            SEAM(pb + 4);
        }
        if (IN(pb + 5, 7)) { PHASE_BEGIN REP(7) norm_phase(X1, xs, a.in[17] + l * DM, modl, 3 * DM, 4 * DM, H, G, PB, modl + 2 * DM, X1 + (size_t)MP * DM); SEAM(pb + 5); }
        if (IN(pb + 6, 8)) { PHASE_BEGIN REP(8) {
            pg8::Gemm g{H, (const bf16_t*)(wl + W_UP), MP, DFF, DM, DM, DM};
            pg8::StaticOrder S; S.init(MP, DFF, G, opaque_bid());
            EpiUp E{FF};
            pg8::gemm_phase<EpiUp, pg8::StaticOrder, true>(lds, g, S, E);
            {   SMALL32_LOOP(DFF, 0) { SMALL32_RC(); f32x4 acc_s[2][2];
                    small_tile32(H + (size_t)MP * DM, DM, (const bf16_t*)(wl + W_UP), DM, DM, row0, col0, lane_s, acc_s);
                    SMALL32_EACH() { SMALL32_ELEM();
                        f32x4 q; q[0] = fmaxf(v[0], 0.f); q[1] = fmaxf(v[1], 0.f); q[2] = fmaxf(v[2], 0.f); q[3] = fmaxf(v[3], 0.f);
                        *(u32x2*)(FF + (size_t)(MP + r) * DFF + col) = pack4(q * q); } }
            } }
            SEAM(pb + 6);
        }
        if (IN(pb + 7, 9)) { PHASE_BEGIN for (int rp_ = 0; rp_ < 1 + MK_PROBE_DOWN; ++rp_) { const float gs = (rp_ == MK_PROBE_DOWN) ? 1.f : 0.f;
#if MK_PROBE_DOWN != 2
            pg8::Gemm g{FF, (const bf16_t*)(wl + W_DOWN), MP, DM, DFF, DFF, DFF};
            pg8::StaticOrder S; S.init(MP, DM, G, opaque_bid());
            EpiRes E{X1, X1 + (size_t)MP * DM, modl + 5 * DM, X1, gs};
            pg8::gemm_phase<EpiRes, pg8::StaticOrder, true>(lds, g, S, E);
#endif
            {   pg8::Gemm g2{FF, (const bf16_t*)(wl + W_DOWN), M, DM, 512, DFF, DFF};
                pg8::SplitKOrder S2{G, opaque_bid(), 8, 512};
                EpiPartial E2{PB, 512};
                pg8::gemm_phase<EpiPartial, pg8::SplitKOrder, true>(lds, g2, S2, E2);
            } }
            SEAM(pb + 7);
        }
    }
    if (IN(18, 10)) { PHASE_BEGIN final_norm_phase(X1, a.in[20], G, PB, mod + (DEPTH - 1) * NMOD + 5 * DM); }
#ifdef MK_DUMP
    { grid.sync();
      const int gt = opaque_bid() * 512 + threadIdx.x, NGT = G * 512;
#if MK_DUMP == 6
      for (int i = gt; i < M * 1024; i += NGT) X1[i] = bf_f(H[i]);
#else
      for (int i = gt; i < M * 512; i += NGT) { const int r = i >> 9, c = i & 511; X1[r * 1024 + c] = bf_f(Db[i]); X1[r * 1024 + 512 + c] = bf_f(Ob[i]); }
#endif
    }
#endif
#undef IN
#undef SEAM
#undef X1
#undef mod
#undef H
#undef Ub
#undef Qb
#undef Kb
#undef Vb
#undef GA
#undef GB
#undef Db
#undef Ob
#undef FF
#undef PB
#undef wl
#undef modl
#undef xp
#undef xs
}

#ifndef MK_PH_HI
#define MK_PH_HI 19
#endif
constexpr int N_PHASES = MK_PH_HI;

extern "C" void kernel_launch(void* const* d_in, const int* in_sizes, int n_in, void* d_out, int out_size, void* d_ws, size_t ws_size, hipStream_t stream) {
    static int grid = 0;
    if (grid == 0) {
        if (n_in != 21 || out_size != OUT_TOTAL || ws_size < WS_END) { fprintf(stderr, "kernel_launch: unexpected shapes: n_in %d out %d ws %zu\n", n_in, out_size, ws_size); grid = -1; return; }
        int dev = 0, cus = 0, per_cu = 0;
        hipGetDevice(&dev);
        hipDeviceGetAttribute(&cus, hipDeviceAttributeMultiprocessorCount, dev);
        if (hipFuncSetAttribute((const void*)fwd_kernel, hipFuncAttributeMaxDynamicSharedMemorySize, LDS_BYTES) != hipSuccess) { fprintf(stderr, "kernel_launch: hipFuncSetAttribute failed\n"); grid = -1; return; }
        if (hipOccupancyMaxActiveBlocksPerMultiprocessor(&per_cu, (const void*)fwd_kernel, 512, LDS_BYTES) != hipSuccess || per_cu < 1) { fprintf(stderr, "kernel_launch: occupancy query failed (%d)\n", per_cu); (void)hipGetLastError(); per_cu = 1; }
        if (per_cu > 1) per_cu = 1;
        grid = cus * per_cu;
        fprintf(stderr, "kernel_launch: grid %d (cus %d)\n", grid, cus);
    }
    if (grid < 0) return;
    if (hipMemsetAsync(d_ws, 0, 65536, stream) != hipSuccess) { fprintf(stderr, "kernel_launch: memset failed\n"); return; }
    Args a{};
    for (int i = 0; i < 21; ++i) a.in[i] = (const float*)d_in[i];
    a.out = (float*)d_out; a.ws = (unsigned char*)d_ws;
#if MK_PER_PHASE
    for (int p = 0; p < N_PHASES; ++p) {
        a.ph_lo = p; a.ph_hi = p + 1;
        hipLaunchKernelGGL(fwd_kernel, dim3(grid), dim3(512), LDS_BYTES, stream, a);
    }
#else
    a.ph_lo = 0; a.ph_hi = N_PHASES;
    void* args[] = {&a};
    hipError_t e = hipLaunchCooperativeKernel((const void*)fwd_kernel, dim3(grid), dim3(512), args, LDS_BYTES, stream);
    if (e != hipSuccess) fprintf(stderr, "kernel_launch: cooperative launch failed: %s (grid %d)\n", hipGetErrorString(e), grid);
#endif
}
```

```cpp
#include <hip/hip_runtime.h>
#include <hip/hip_cooperative_groups.h>
#include <cstdio>
#include <cstdint>
namespace cg = cooperative_groups;

#ifndef MK_PER_PHASE
#define MK_PER_PHASE 0
#endif

#define LAS __attribute__((address_space(3)))
#define DI __device__ __forceinline__
typedef unsigned short bf16_t;
typedef short bf16x8 __attribute__((ext_vector_type(8)));
typedef short s16x4 __attribute__((ext_vector_type(4)));
typedef float f32x4 __attribute__((ext_vector_type(4)));
typedef float f32x2 __attribute__((ext_vector_type(2)));
typedef float f32x16 __attribute__((ext_vector_type(16)));
typedef unsigned u32x4 __attribute__((ext_vector_type(4)));
typedef unsigned u32x2 __attribute__((ext_vector_type(2)));

constexpr int DM = 1024, NB = 8, SEQ = 2048, DEPTH = 2, DB = 128, DS = 4, WIN = 128, PW = 512, PPAD = 15;
constexpr int MP = NB * SEQ;
constexpr int MS = DB * DS;
constexpr int M = MP + MS;
constexpr int NIN = 3328, DFF = 4096, NMOD = 6 * DM, NMODROWS = NB + DB;
constexpr int OFF_Y = 0;
constexpr int OFF_KP = M * DM;
constexpr int OFF_VP = OFF_KP + DEPTH * NB * WIN * 128;
constexpr int OFF_PP = OFF_VP + DEPTH * NB * WIN * 128;
constexpr int OFF_KS = OFF_PP + DEPTH * NB * PPAD * PW;
constexpr int OFF_VS = OFF_KS + DEPTH * DB * WIN * 128;
constexpr int OFF_PS = OFF_VS + DEPTH * DB * WIN * 128;
constexpr int OUT_TOTAL = OFF_PS + DEPTH * DB * PPAD * PW;
static_assert(OUT_TOTAL == 28303360, "d_out map");
constexpr size_t MiB = 1u << 20;
constexpr size_t WS_SC = 1 * MiB;
constexpr size_t WS_MOD = 2 * MiB;
constexpr size_t WS_W = 9 * MiB, WS_WL = 27 * MiB;
constexpr size_t W_IN = 0, W_PA = 13 * MiB / 2, W_B = 15 * MiB / 2, W_OUT = 17 * MiB / 2, W_UP = 21 * MiB / 2, W_DOWN = 37 * MiB / 2;
constexpr size_t WS_H = 63 * MiB;
constexpr size_t WS_Z = 96 * MiB;
constexpr size_t WS_U = WS_Z, WS_Q = WS_U + (size_t)M * 512 * 2, WS_K = WS_Q + (size_t)M * 512 * 2, WS_V = WS_K + (size_t)M * 128 * 2,
                 WS_GA = WS_V + (size_t)M * 128 * 2, WS_GB = WS_GA + (size_t)M * 1024 * 2, WS_D = WS_GB + (size_t)M * 1024 * 2,
                 WS_O = WS_D + (size_t)M * 512 * 2, WS_ZEND = WS_O + (size_t)M * 512 * 2;
constexpr size_t WS_FF = WS_Z;
constexpr size_t WS_WADA = WS_Z;
constexpr size_t WS_PB = 228 * MiB;
constexpr size_t WS_END = 244 * MiB;
static_assert(WS_PB + (size_t)8 * MS * DM * 4 <= WS_END && WS_FF + (size_t)M * DFF * 2 <= WS_PB && WS_ZEND <= WS_END && WS_FF + (size_t)M * DFF * 2 <= WS_END && W_DOWN + 8 * MiB <= WS_WL && WS_W + 2 * WS_WL <= WS_H && WS_H + (size_t)M * 2048 <= WS_Z, "ws map");

constexpr int LDS_BYTES = 147456;

DI int opaque_bid() { int b = blockIdx.x; asm volatile("" : "+s"(b)); return b; }
DI int opaque_tid() { int t = threadIdx.x; asm volatile("" : "+v"(t)); return t; }
typedef __bf16 bf16x2_t __attribute__((ext_vector_type(2)));
DI unsigned cvt_pk_bf16(float lo, float hi) { f32x2 v = {lo, hi}; bf16x2_t b = __builtin_convertvector(v, bf16x2_t); return __builtin_bit_cast(unsigned, b); }
DI float bf_lo(unsigned w) { return __uint_as_float(w << 16); }
DI float bf_hi(unsigned w) { return __uint_as_float(w & 0xffff0000u); }
DI float bf_f(bf16_t h) { return __uint_as_float(((unsigned)h) << 16); }
DI u32x4 pack8(f32x4 a, f32x4 b) { u32x4 w; w.x = cvt_pk_bf16(a[0], a[1]); w.y = cvt_pk_bf16(a[2], a[3]); w.z = cvt_pk_bf16(b[0], b[1]); w.w = cvt_pk_bf16(b[2], b[3]); return w; }
DI float sigmoidf_(float v) { return __builtin_amdgcn_rcpf(1.0f + __expf(-v)); }
DI int modrow(int row) { return row < MP ? (row >> 11) : NB + ((row - MP) >> 2); }
DI float shfl_xor_l(float v, int o, int lane) { return __builtin_bit_cast(float, __builtin_amdgcn_ds_bpermute((lane ^ o) << 2, __builtin_bit_cast(int, v))); }
DI float wave_sum(float v, int lane) {
#pragma unroll
    for (int o = 1; o < 64; o <<= 1) v += shfl_xor_l(v, o, lane);
    return v;
}
DI float wave_max(float v, int lane) {
#pragma unroll
    for (int o = 1; o < 64; o <<= 1) v = fmaxf(v, shfl_xor_l(v, o, lane));
    return v;
}

namespace pg8 {
constexpr int BM = 256, BK = 64, HALF = 128, HTB = HALF * BK * 2, STAGE_BYTES = 8 * HTB, NXCD = 8, WGM = 8;
__host__ __device__ __forceinline__ int lds_byte(int r, int c) { const int st = (r >> 4) * 2 + (c >> 5), rr = r & 15, cc = c & 31, ob = rr * 64 + cc * 2; return st * 1024 + (ob ^ (((ob >> 9) & 1) << 5)); }
__host__ __device__ __forceinline__ void stage_rc(int b, int& R, int& C) { const int st = b / 1024, sb = b % 1024, swz = sb ^ (((sb >> 9) & 1) << 5); R = (st >> 1) * 16 + swz / 64; C = (st & 1) * 32 + (swz % 64) / 2; }
__host__ __device__ __forceinline__ int perm32(int rho) { const int n = rho >> 4, i = rho & 15; return 8 * (i >> 2) + 4 * n + (i & 3); }

struct Unit { int pm, pn, ko; };
struct Gemm { const bf16_t* A; const bf16_t* Bt; int M, N, K, lda, ldb; };

struct StaticOrder {
    int nM, nN, nwg, G, c;
    __host__ __device__ void init(int M_, int N_, int G_, int c_) { nM = M_ / BM; nN = N_ / BM; nwg = nM * nN; G = G_; c = c_; }
    __host__ __device__ bool next(int i, Unit& u) const {
        const long L = (long)i * G + c; if (L >= nwg) return false;
        int wgid = (int)L; { const int q = nwg / NXCD, r = nwg % NXCD, xcd = wgid % NXCD, off = wgid / NXCD; wgid = (xcd < r ? xcd * (q + 1) : r * (q + 1) + (xcd - r) * q) + off; }
        const int nig = WGM * nN, gid = wgid / nig, fm = gid * WGM, gsz = (nM - fm) < WGM ? (nM - fm) : WGM;
        u.pm = fm + ((wgid % nig) % gsz); u.pn = (wgid % nig) / gsz; u.ko = 0; return true;
    }
};
struct SplitKOrder {
    int G, c, S, Kc;
    __host__ __device__ bool next(int i, Unit& u) const { const int L = i * G + c; if (L >= 8 * S) return false; const int tile = L & 7; u.pm = 64 + (tile >> 2); u.pn = tile & 3; u.ko = (L >> 3) * Kc; return true; }
};

template <class Epi, class Sched, bool ALIGN_EPI>
__device__ __forceinline__ void gemm_phase(LAS unsigned char* lds, const Gemm g, const Sched& S, const Epi& E) {
    const int tid = opaque_tid(), wid = __builtin_amdgcn_readfirstlane(tid >> 6), lane = tid & 63, wr = wid >> 2, wc = wid & 3, fr = lane & 15, fq = lane >> 4;
    const int K = g.K, nt = K / BK;
    unsigned voffA[2], voffB[2];
#pragma unroll
    for (int i = 0; i < 2; ++i) { int R, C; stage_rc(tid * 16 + i * 8192, R, C); const int Rb = Epi::PERM ? ((R & ~31) + perm32(R & 31)) : R;
        voffA[i] = (unsigned)(R * g.lda + C) * 2u; voffB[i] = (unsigned)(Rb * g.ldb + C) * 2u; }
    const size_t kstep = (size_t)(BK * 2);
    const size_t hA = (size_t)HALF * g.lda * 2, hB = (size_t)HALF * g.ldb * 2;
    const size_t tA = 2 * hA, tB = 2 * hB;
    const unsigned ldsw = (unsigned)wid * 1024u;
    const int aoff = lds_byte(wr * 64 + fr, fq * 8), boff = lds_byte(wc * 32 + fr, fq * 8);
#define PG8_SA(b, h) (((b) * 2 + (h)) * HTB)
#define PG8_SB(b, h) ((4 + (b) * 2 + (h)) * HTB)
#define PG8_STAGE(bufoff, gbase, voff) do { _Pragma("unroll") for (int _i = 0; _i < 2; ++_i) \
        __builtin_amdgcn_global_load_lds((const unsigned*)((const char*)(gbase) + (voff)[_i]), (LAS unsigned*)(lds + (bufoff) + ldsw + _i * 8192), 16, 0, 0); } while (0)
#define PG8_LDA(dst, b, h) do { _Pragma("unroll") for (int m = 0; m < 4; ++m) _Pragma("unroll") for (int k = 0; k < 2; ++k) dst[m][k] = *(const LAS bf16x8*)(lds + PG8_SA(b, h) + aoff + m * 2048 + k * 1024); } while (0)
#define PG8_LDB(dst, b, h) do { _Pragma("unroll") for (int n = 0; n < 2; ++n) _Pragma("unroll") for (int k = 0; k < 2; ++k) dst[n][k] = *(const LAS bf16x8*)(lds + PG8_SB(b, h) + boff + n * 2048 + k * 1024); } while (0)
#define PG8_MMA(ai, bj, At, Bt) do { __builtin_amdgcn_s_setprio(1); _Pragma("unroll") for (int m = 0; m < 4; ++m) _Pragma("unroll") for (int n = 0; n < 2; ++n) _Pragma("unroll") for (int k = 0; k < 2; ++k) \
        acc[ai][bj][m][n] = __builtin_amdgcn_mfma_f32_16x16x32_bf16(Bt[n][k], At[m][k], acc[ai][bj][m][n], 0, 0, 0); __builtin_amdgcn_s_setprio(0); } while (0)
#define PG8_WAIT_V(n) asm volatile("s_waitcnt vmcnt(" #n ")" ::: "memory")
#define PG8_WAIT_L(n) asm volatile("s_waitcnt lgkmcnt(" #n ")" ::: "memory")
#define PG8_BAR __builtin_amdgcn_s_barrier()
#define PG8_SCHED __builtin_amdgcn_sched_barrier(0)
    Unit cur, nxt; int ui = 0;
    if (!S.next(0, cur)) return;
    f32x4 acc[2][2][4][2];
#pragma unroll
    for (int a = 0; a < 2; ++a)
#pragma unroll
        for (int b = 0; b < 2; ++b)
#pragma unroll
            for (int m = 0; m < 4; ++m)
#pragma unroll
                for (int n = 0; n < 2; ++n) acc[a][b][m][n] = (f32x4){0.f, 0.f, 0.f, 0.f};
    bf16x8 At[4][2], B0[2][2], B1[2][2];
    const char* cA = (const char*)g.A + (size_t)cur.pm * tA + (size_t)cur.ko * 2; const char* cB = (const char*)g.Bt + (size_t)cur.pn * tB + (size_t)cur.ko * 2;
    PG8_STAGE(PG8_SB(0, 0), cB, voffB); PG8_STAGE(PG8_SB(0, 1), cB + hB, voffB); PG8_STAGE(PG8_SA(0, 0), cA, voffA); PG8_STAGE(PG8_SA(0, 1), cA + hA, voffA);
    if (wr == 1) PG8_BAR;
    PG8_WAIT_V(2); PG8_BAR;
    PG8_STAGE(PG8_SB(1, 0), cB + kstep, voffB); PG8_STAGE(PG8_SA(1, 0), cA + kstep, voffA); PG8_STAGE(PG8_SB(1, 1), cB + hB + kstep, voffB);
    PG8_WAIT_V(6); PG8_BAR;
    for (;;) {
        const bool has_next = S.next(ui + 1, nxt);
        const char* nA = has_next ? (const char*)g.A + (size_t)nxt.pm * tA + (size_t)nxt.ko * 2 : cA; const char* nB = has_next ? (const char*)g.Bt + (size_t)nxt.pn * tB + (size_t)nxt.ko * 2 : cB;
        for (int t = 0; t < nt; t += 2) {
            const bool last = (t == nt - 2);
            const char* a1 = cA + (size_t)(t + 1) * kstep;
            const char* a2 = last ? nA : cA + (size_t)(t + 2) * kstep; const char* b2 = last ? nB : cB + (size_t)(t + 2) * kstep;
            const char* a3 = a2 + kstep; const char* b3 = b2 + kstep;
            PG8_LDB(B0, 0, 0); PG8_LDB(B1, 0, 1); PG8_SCHED; PG8_LDA(At, 0, 0); PG8_STAGE(PG8_SA(1, 1), a1 + hA, voffA);
            PG8_WAIT_V(8); PG8_WAIT_L(0); PG8_BAR; PG8_MMA(0, 0, At, B0); PG8_MMA(0, 1, At, B1); PG8_BAR; PG8_SCHED;
            PG8_LDA(At, 0, 1); PG8_STAGE(PG8_SB(0, 0), b2, voffB); PG8_STAGE(PG8_SB(0, 1), b2 + hB, voffB); PG8_STAGE(PG8_SA(0, 0), a2, voffA);
            PG8_WAIT_V(8); PG8_WAIT_L(0); PG8_BAR; PG8_MMA(1, 0, At, B0); PG8_MMA(1, 1, At, B1); PG8_BAR; PG8_SCHED;
            PG8_LDB(B0, 1, 0); PG8_LDB(B1, 1, 1); PG8_SCHED; PG8_LDA(At, 1, 0); PG8_STAGE(PG8_SA(0, 1), a2 + hA, voffA);
            PG8_WAIT_V(8); PG8_WAIT_L(0); PG8_BAR; PG8_MMA(0, 0, At, B0); PG8_MMA(0, 1, At, B1); PG8_BAR; PG8_SCHED;
            PG8_LDA(At, 1, 1); PG8_STAGE(PG8_SB(1, 0), b3, voffB); PG8_STAGE(PG8_SB(1, 1), b3 + hB, voffB); PG8_STAGE(PG8_SA(1, 0), a3, voffA);
            PG8_WAIT_V(8); PG8_WAIT_L(0); PG8_BAR; PG8_MMA(1, 0, At, B0); PG8_MMA(1, 1, At, B1); PG8_BAR; PG8_SCHED;
        }
        if constexpr (ALIGN_EPI) { if (wr == 0) PG8_BAR; }
        E(acc, cur, wr, wc, fr, fq);
        if (!has_next) break;
#pragma unroll
        for (int a = 0; a < 2; ++a)
#pragma unroll
            for (int b = 0; b < 2; ++b)
#pragma unroll
                for (int m = 0; m < 4; ++m)
#pragma unroll
                    for (int n = 0; n < 2; ++n) acc[a][b][m][n] = (f32x4){0.f, 0.f, 0.f, 0.f};
        cur = nxt; cA = nA; cB = nB; ++ui;
        if constexpr (ALIGN_EPI) { if (wr == 1) PG8_BAR; }
    }
    PG8_WAIT_V(0);
    if constexpr (!ALIGN_EPI) { if (wr == 0) PG8_BAR; }
    PG8_BAR;
#undef PG8_SA
#undef PG8_SB
#undef PG8_STAGE
#undef PG8_LDA
#undef PG8_LDB
#undef PG8_MMA
#undef PG8_WAIT_V
#undef PG8_WAIT_L
#undef PG8_BAR
#undef PG8_SCHED
}
}
using pg8::Unit;

struct EpiAda {
    static constexpr bool PERM = false;
    float* mod; const float* bias;
    DI void operator()(const f32x4 (&acc)[2][2][4][2], const Unit& u, int wr, int wc, int fr, int fq) const {
#pragma unroll
        for (int ai = 0; ai < 2; ++ai)
#pragma unroll
            for (int m = 0; m < 4; ++m) { const int row = u.pm * 256 + ai * 128 + wr * 64 + m * 16 + fr;
                if (row < NMODROWS) {
#pragma unroll
                    for (int bj = 0; bj < 2; ++bj)
#pragma unroll
                        for (int n = 0; n < 2; ++n) { const int col = u.pn * 256 + bj * 128 + wc * 32 + n * 16 + fq * 4;
                            *(f32x4*)(mod + (size_t)row * (2 * NMOD) + col) = acc[ai][bj][m][n] + *(const f32x4*)(bias + col); } } }
    }
};
struct EpiIn {
    static constexpr bool PERM = true;
    bf16_t *U, *Q, *Kb, *Vb, *GA, *GB; float* out; int layer;
    DI void operator()(const f32x4 (&acc)[2][2][4][2], const Unit& u, int wr, int wc, int fr, int fq) const {
        const int pn = u.pn, cw = wc * 32 + 8 * fq;
#pragma unroll
        for (int ai = 0; ai < 2; ++ai)
#pragma unroll
            for (int m = 0; m < 4; ++m) { const int row = u.pm * 256 + ai * 128 + wr * 64 + m * 16 + fr;
#pragma unroll
                for (int bj = 0; bj < 2; ++bj) { f32x4 v0 = acc[ai][bj][m][0], v1 = acc[ai][bj][m][1]; const int c256 = bj * 128 + cw;
                    if (pn < 2) {
                        const int col = pn * 256 + c256;
                        *(u32x4*)(U + (size_t)row * 512 + col) = pack8(v0, v1);
                        float* po = nullptr;
                        { const int t = row & 2047; if (t >= SEQ - PPAD) po = out + OFF_PP + ((layer * NB + (row >> 11)) * PPAD + (t - (SEQ - PPAD))) * PW + col; }
                        if (po) { *(f32x4*)po = v0; *(f32x4*)(po + 4) = v1; }
                    } else if (pn < 4) {
                        const int col = (pn - 2) * 256 + c256;
                        *(u32x4*)(Q + (size_t)row * 512 + col) = pack8(v0 * 0.125f, v1 * 0.125f);
                    } else if (pn == 4) {
                        bf16_t* dst = bj == 0 ? Kb : Vb;
                        *(u32x4*)(dst + (size_t)row * 128 + cw) = pack8(v0, v1);
                        float* po = nullptr;
                        { const int t = row & 2047; if (t >= SEQ - WIN) po = out + (bj == 0 ? OFF_KP : OFF_VP) + ((layer * NB + (row >> 11)) * WIN + (t - (SEQ - WIN))) * 128 + cw; }
                        if (po) { *(f32x4*)po = v0; *(f32x4*)(po + 4) = v1; }
                    } else {
                        f32x4 s0, s1;
#pragma unroll
                        for (int e = 0; e < 4; ++e) { s0[e] = sigmoidf_(v0[e]); s1[e] = sigmoidf_(v1[e]); }
                        bf16_t* dst = pn < 9 ? GA + (pn - 5) * 256 : GB + (pn - 9) * 256;
                        *(u32x4*)(dst + (size_t)row * 1024 + c256) = pack8(s0, s1);
                    } } }
    }
};
template <int SECOND> struct EpiMix {
    static constexpr bool PERM = true;
    const bf16_t* G; bf16_t* MG;
    DI void operator()(const f32x4 (&acc)[2][2][4][2], const Unit& u, int wr, int wc, int fr, int fq) const {
        const unsigned col0 = (unsigned)(u.pn * 256 + wc * 32 + 8 * fq);
#pragma unroll
        for (int ai = 0; ai < 2; ++ai) {
            u32x4 gw[4][2], pw[4][2];
#pragma unroll
            for (int m = 0; m < 4; ++m)
#pragma unroll
                for (int bj = 0; bj < 2; ++bj) { const size_t off = (size_t)(u.pm * 256 + ai * 128 + wr * 64 + m * 16 + fr) * 1024 + col0 + bj * 128;
                    gw[m][bj] = *(const u32x4*)(G + off); if (SECOND) pw[m][bj] = *(const u32x4*)(MG + off); }
#pragma unroll
            for (int m = 0; m < 4; ++m)
#pragma unroll
                for (int bj = 0; bj < 2; ++bj) { const size_t off = (size_t)(u.pm * 256 + ai * 128 + wr * 64 + m * 16 + fr) * 1024 + col0 + bj * 128;
                    const u32x4 g4 = gw[m][bj]; f32x4 v0 = acc[ai][bj][m][0], v1 = acc[ai][bj][m][1];
                    v0[0] *= bf_lo(g4.x); v0[1] *= bf_hi(g4.x); v0[2] *= bf_lo(g4.y); v0[3] *= bf_hi(g4.y);
                    v1[0] *= bf_lo(g4.z); v1[1] *= bf_hi(g4.z); v1[2] *= bf_lo(g4.w); v1[3] *= bf_hi(g4.w);
                    if (SECOND) { const u32x4 p4 = pw[m][bj];
                        v0[0] += bf_lo(p4.x); v0[1] += bf_hi(p4.x); v0[2] += bf_lo(p4.y); v0[3] += bf_hi(p4.y);
                        v1[0] += bf_lo(p4.z); v1[1] += bf_hi(p4.z); v1[2] += bf_lo(p4.w); v1[3] += bf_hi(p4.w); }
                    *(u32x4*)(MG + off) = pack8(v0, v1); }
        }
    }
};
struct EpiRes {
    static constexpr bool PERM = false;
    const float *xp, *xs; const float* gate; float* X1; float gs;
    DI void operator()(const f32x4 (&acc)[2][2][4][2], const Unit& u, int wr, int wc, int fr, int fq) const {
        const unsigned colb = (unsigned)(u.pn * 256 + wc * 32 + fq * 4) * 4u;
        const char* gbase = (const char*)gate + (size_t)((u.pm * 256) >> 11) * (2 * NMOD) * 4;
        const char* xb = (const char*)xp; char* ob = (char*)X1;
#pragma unroll
        for (int ai = 0; ai < 2; ++ai)
#pragma unroll
            for (int m = 0; m < 4; ++m) { const unsigned rowb = (unsigned)(u.pm * 256 + ai * 128 + wr * 64 + m * 16 + fr) * (unsigned)(DM * 4);
                f32x4 xv[2][2], gv[2][2];
#pragma unroll
                for (int bj = 0; bj < 2; ++bj)
#pragma unroll
                    for (int n = 0; n < 2; ++n) { xv[bj][n] = *(const f32x4*)(xb + (rowb + colb + (unsigned)(bj * 128 + n * 16) * 4u)); gv[bj][n] = *(const f32x4*)(gbase + colb + (unsigned)(bj * 128 + n * 16) * 4u) * gs; }
#pragma unroll
                for (int bj = 0; bj < 2; ++bj)
#pragma unroll
                    for (int n = 0; n < 2; ++n) *(f32x4*)(ob + (rowb + colb + (unsigned)(bj * 128 + n * 16) * 4u)) = xv[bj][n] + gv[bj][n] * acc[ai][bj][m][n]; }
    }
};
struct EpiPartial {
    static constexpr bool PERM = false;
    float* PB; int Kc;
    DI void operator()(const f32x4 (&acc)[2][2][4][2], const Unit& u, int wr, int wc, int fr, int fq) const {
        float* pb = PB + (size_t)(u.ko / Kc) * MS * DM;
#pragma unroll
        for (int ai = 0; ai < 2; ++ai)
#pragma unroll
            for (int m = 0; m < 4; ++m) { const int r = u.pm * 256 + ai * 128 + wr * 64 + m * 16 + fr - MP;
#pragma unroll
                for (int bj = 0; bj < 2; ++bj)
#pragma unroll
                    for (int n = 0; n < 2; ++n) { const int col = u.pn * 256 + bj * 128 + wc * 32 + n * 16 + fq * 4;
                        *(f32x4*)(pb + (size_t)r * DM + col) = acc[ai][bj][m][n]; } }
    }
};
struct EpiUp {
    static constexpr bool PERM = true;
    bf16_t* FF;
    DI void operator()(const f32x4 (&acc)[2][2][4][2], const Unit& u, int wr, int wc, int fr, int fq) const {
        const __amdgpu_buffer_rsrc_t ffr = __builtin_amdgcn_make_buffer_rsrc(FF, 0, (int)((size_t)M * DFF * 2), 0x00020000);
#pragma unroll
        for (int ai = 0; ai < 2; ++ai)
#pragma unroll
            for (int m = 0; m < 4; ++m) { const int row = u.pm * 256 + ai * 128 + wr * 64 + m * 16 + fr;
#pragma unroll
                for (int bj = 0; bj < 2; ++bj) { const int col = u.pn * 256 + bj * 128 + wc * 32 + 8 * fq;
                    f32x4 v0 = acc[ai][bj][m][0], v1 = acc[ai][bj][m][1];
#pragma unroll
                    for (int e = 0; e < 4; ++e) { const float a = fmaxf(v0[e], 0.f), b = fmaxf(v1[e], 0.f); v0[e] = a * a; v1[e] = b * b; }
                    __builtin_amdgcn_raw_buffer_store_b128(pack8(v0, v1), ffr, (unsigned)(row * DFF + col) * 2u, 0,   0); } }
    }
};

struct Args { const float* in[21]; float* out; unsigned char* ws; int ph_lo, ph_hi; };

DI void transpose_item(const float* W, int K, int N, bf16_t* WT, int row_off, LAS float* scr, int item, int lane) {
    const int nblk = N / 32, kb = item / nblk, nb = item % nblk, k0 = 64 * kb, n0 = 32 * nb;
#pragma unroll 8
    for (int i = 0; i < 32; ++i) { const int kk = 2 * i + (lane >> 5); scr[kk * 33 + (lane & 31)] = W[(size_t)(k0 + kk) * N + n0 + (lane & 31)]; }
    asm volatile("s_waitcnt lgkmcnt(0)" ::: "memory");
    const int c = lane & 7;
#pragma unroll
    for (int j = 0; j < 4; ++j) { const int n = (lane >> 3) + 8 * j; const LAS float* s = scr + (8 * c) * 33 + n;
        u32x4 o; o.x = cvt_pk_bf16(s[0 * 33], s[1 * 33]); o.y = cvt_pk_bf16(s[2 * 33], s[3 * 33]); o.z = cvt_pk_bf16(s[4 * 33], s[5 * 33]); o.w = cvt_pk_bf16(s[6 * 33], s[7 * 33]);
        *(u32x4*)(WT + (size_t)(row_off + n0 + n) * K + k0 + 8 * c) = o; }
    asm volatile("s_waitcnt lgkmcnt(0)" ::: "memory");
}

DI void prologue(const Args& a, LAS unsigned char* lds, int G) {
    const int tid = opaque_tid(), lane = tid & 63, wave = tid >> 6;
    LAS float* scr = (LAS float*)(lds + wave * 16384);
    const int gw = opaque_bid() * 8 + wave, NGW = G * 8;
    unsigned char* ws = a.ws;
    constexpr int I_IN = (DM / 64) * (NIN / 32), I_B = (PW / 64) * (DM / 32), I_OUT = (DM / 64) * (DM / 32), I_UP = (DM / 64) * (DFF / 32), I_DOWN = (DFF / 64) * (DM / 32), I_ADA = (DM / 64) * (NMOD / 32);
    constexpr int I_LAYER = I_IN + I_B + I_OUT + I_UP + I_DOWN + I_ADA;
    for (int it = gw; it < 2 * I_LAYER; it += NGW) {
        const int l = it / I_LAYER; int r = it % I_LAYER;
        unsigned char* wl = ws + WS_W + (size_t)l * WS_WL;
        if (r < I_IN) { transpose_item(a.in[10] + (size_t)l * DM * NIN, DM, NIN, (bf16_t*)(wl + W_IN), 0, scr, r, lane); continue; } r -= I_IN;
        if (r < I_B) { transpose_item(a.in[15] + (size_t)l * PW * DM, PW, DM, (bf16_t*)(wl + W_B), 0, scr, r, lane); continue; } r -= I_B;
        if (r < I_OUT) { transpose_item(a.in[16] + (size_t)l * DM * DM, DM, DM, (bf16_t*)(wl + W_OUT), 0, scr, r, lane); continue; } r -= I_OUT;
        if (r < I_UP) { transpose_item(a.in[18] + (size_t)l * DM * DFF, DM, DFF, (bf16_t*)(wl + W_UP), 0, scr, r, lane); continue; } r -= I_UP;
        if (r < I_DOWN) { transpose_item(a.in[19] + (size_t)l * DFF * DM, DFF, DM, (bf16_t*)(wl + W_DOWN), 0, scr, r, lane); continue; } r -= I_DOWN;
        transpose_item(a.in[7] + (size_t)l * DM * NMOD, DM, NMOD, (bf16_t*)(ws + WS_WADA), l * NMOD, scr, r, lane);
    }
    const int gt = opaque_bid() * 512 + tid, NGT = G * 512;
    for (int it = gt; it < 2 * 65536; it += NGT) {
        const int l = it >> 16, rem = it & 65535, cgp = rem >> 10, n = rem & 1023, g = cgp >> 4, c0 = (cgp & 15) * 8;
        const float* wa = a.in[14] + (size_t)l * PW * DM + (size_t)(g * 128) * DM + n;
        const float* ps = a.in[12] + l * PW + g * 128;
        const float* wp = a.in[11] + ((size_t)(l * 4 + g) * 128 + c0) * 128;
        float acc[8];
#pragma unroll
        for (int j = 0; j < 8; ++j) acc[j] = 0.f;
#pragma unroll 16
        for (int d = 0; d < 128; ++d) { const float wv = wa[(size_t)d * DM] * ps[d];
#pragma unroll
            for (int j = 0; j < 8; ++j) acc[j] += wp[j * 128 + d] * wv; }
        u32x4 o; o.x = cvt_pk_bf16(acc[0], acc[1]); o.y = cvt_pk_bf16(acc[2], acc[3]); o.z = cvt_pk_bf16(acc[4], acc[5]); o.w = cvt_pk_bf16(acc[6], acc[7]);
        *(u32x4*)((bf16_t*)(ws + WS_W + (size_t)l * WS_WL + W_PA) + (size_t)n * PW + g * 128 + c0) = o;
    }
    for (int it = gt; it < 256 * DM / 2; it += NGT) {
        const int r = it >> 9, c2 = (it & 511) * 2; float v0 = 0.f, v1 = 0.f;
        if (r < NMODROWS) { const float* cp = r < NB ? a.in[5] + r * DM : a.in[6] + (r - NB) * DM; v0 = cp[c2]; v1 = cp[c2 + 1]; v0 = v0 * sigmoidf_(v0); v1 = v1 * sigmoidf_(v1); }
        ((unsigned*)(ws + WS_SC))[it] = cvt_pk_bf16(v0, v1);
    }
    for (int it = gt; it < MS * DM / 4; it += NGT) ((f32x4*)(a.out + OFF_Y + (size_t)MP * DM))[it] = ((const f32x4*)a.in[1])[it];
}

DI void rolling_copy(const Args& a, int l, int G) {
    const int gt = opaque_bid() * 512 + opaque_tid(), NGT = G * 512;
    constexpr int KV4 = (WIN - DS) * 128 / 4;
    for (int it = gt; it < DB * KV4; it += NGT) { const int lb = l * DB + it / KV4, e = it % KV4;
        ((f32x4*)(a.out + OFF_KS + (size_t)lb * WIN * 128))[e] = ((const f32x4*)(a.in[2] + (size_t)lb * WIN * 128 + DS * 128))[e];
        ((f32x4*)(a.out + OFF_VS + (size_t)lb * WIN * 128))[e] = ((const f32x4*)(a.in[3] + (size_t)lb * WIN * 128 + DS * 128))[e]; }
    constexpr int P4 = (PPAD - DS) * PW / 4;
    for (int it = gt; it < DB * P4; it += NGT) { const int lb = l * DB + it / P4, e = it % P4;
        ((f32x4*)(a.out + OFF_PS + (size_t)lb * PPAD * PW))[e] = ((const f32x4*)(a.in[4] + (size_t)lb * PPAD * PW + DS * PW))[e]; }
}

DI void norm_store_row(const f32x4 (&v)[4], float rstd, int row, int lane, const float* g, const float* mr, int sh_off, int sc_off, bf16_t* H) {
#pragma unroll
    for (int j = 0; j < 4; ++j) { const int c = lane * 4 + 256 * j;
        const f32x4 gg = *(const f32x4*)(g + c), sc = *(const f32x4*)(mr + sc_off + c), sh = *(const f32x4*)(mr + sh_off + c);
        const f32x4 h = v[j] * rstd * gg * (sc + 1.0f) + sh;
        u32x2 w; w.x = cvt_pk_bf16(h.x, h.y); w.y = cvt_pk_bf16(h.z, h.w);
        *(u32x2*)(H + (size_t)row * DM + c) = w; }
}
DI float norm_ss(const f32x4 (&v)[4]) { float s = 0.f;
#pragma unroll
    for (int j = 0; j < 4; ++j) s += (v[j].x * v[j].x + v[j].y * v[j].y) + (v[j].z * v[j].z + v[j].w * v[j].w);
    return s; }
DI void norm_phase(const float* xp, const float* xs, const float* g, const float* mod, int sh_off, int sc_off, bf16_t* H, int G, const float* pb, const float* pgate, float* xw) {
    const int tid_ = opaque_tid(), lane = tid_ & 63, gw = opaque_bid() * 8 + (tid_ >> 6), NGW = G * 8;
    if (gw < MP) {
        f32x4 cur[4], nxt[4];
#pragma unroll
        for (int j = 0; j < 4; ++j) cur[j] = *(const f32x4*)(xp + (size_t)gw * DM + lane * 4 + 256 * j);
        for (int row = gw; row < MP; row += NGW) {
            const int rn = row + NGW < MP ? row + NGW : row;
#pragma unroll
            for (int j = 0; j < 4; ++j) nxt[j] = *(const f32x4*)(xp + (size_t)rn * DM + lane * 4 + 256 * j);
            const float rstd = rsqrtf(wave_sum(norm_ss(cur), lane) * (1.f / DM) + 1e-6f);
            norm_store_row(cur, rstd, row, lane, g, mod + (size_t)(row >> 11) * (2 * NMOD), sh_off, sc_off, H);
#pragma unroll
            for (int j = 0; j < 4; ++j) cur[j] = nxt[j];
        }
    }
    for (int row = MP + gw; row < M; row += NGW) {
        const int r = row - MP; f32x4 v[4];
#pragma unroll
        for (int j = 0; j < 4; ++j) v[j] = *(const f32x4*)(xs + (size_t)r * DM + lane * 4 + 256 * j);
        if (pb) {
            const float* gr = pgate + (size_t)modrow(row) * (2 * NMOD);
#pragma unroll
            for (int j = 0; j < 4; ++j) { const int c = lane * 4 + 256 * j; f32x4 sum = {0.f, 0.f, 0.f, 0.f};
#pragma unroll
                for (int sk = 0; sk < 8; ++sk) sum += *(const f32x4*)(pb + ((size_t)sk * MS + r) * DM + c);
                v[j] += *(const f32x4*)(gr + c) * sum; *(f32x4*)(xw + (size_t)r * DM + c) = v[j]; }
        }
        const float rstd = rsqrtf(wave_sum(norm_ss(v), lane) * (1.f / DM) + 1e-6f);
        norm_store_row(v, rstd, row, lane, g, mod + (size_t)modrow(row) * (2 * NMOD), sh_off, sc_off, H);
    }
}
DI void final_norm_phase(float* X, const float* g, int G, const float* pb, const float* pgate) {
    const int tid_ = opaque_tid(), lane = tid_ & 63, gw = opaque_bid() * 8 + (tid_ >> 6), NGW = G * 8;
    if (gw < MP) {
        f32x4 cur[4], nxt[4];
#pragma unroll
        for (int j = 0; j < 4; ++j) cur[j] = *(const f32x4*)(X + (size_t)gw * DM + lane * 4 + 256 * j);
        for (int row = gw; row < MP; row += NGW) {
            const int rn = row + NGW < MP ? row + NGW : row;
#pragma unroll
            for (int j = 0; j < 4; ++j) nxt[j] = *(const f32x4*)(X + (size_t)rn * DM + lane * 4 + 256 * j);
            const float rstd = rsqrtf(wave_sum(norm_ss(cur), lane) * (1.f / DM) + 1e-6f);
#pragma unroll
            for (int j = 0; j < 4; ++j) { const int c = lane * 4 + 256 * j; *(f32x4*)(X + (size_t)row * DM + c) = cur[j] * rstd * *(const f32x4*)(g + c); }
#pragma unroll
            for (int j = 0; j < 4; ++j) cur[j] = nxt[j];
        }
    }
    for (int row = MP + gw; row < M; row += NGW) {
        const int r = row - MP; float* xr = X + (size_t)row * DM; const float* gr = pgate + (size_t)modrow(row) * (2 * NMOD);
        f32x4 v[4];
#pragma unroll
        for (int j = 0; j < 4; ++j) v[j] = *(const f32x4*)(xr + lane * 4 + 256 * j);
#pragma unroll
        for (int j = 0; j < 4; ++j) { const int c = lane * 4 + 256 * j; f32x4 sum = {0.f, 0.f, 0.f, 0.f};
#pragma unroll
            for (int sk = 0; sk < 8; ++sk) sum += *(const f32x4*)(pb + ((size_t)sk * MS + r) * DM + c);
            v[j] += *(const f32x4*)(gr + c) * sum; }
        const float rstd = rsqrtf(wave_sum(norm_ss(v), lane) * (1.f / DM) + 1e-6f);
#pragma unroll
        for (int j = 0; j < 4; ++j) { const int c = lane * 4 + 256 * j; *(f32x4*)(xr + c) = v[j] * rstd * *(const f32x4*)(g + c); }
    }
}

template <int R, bool SAMPLE>
DI void pool_rows(const bf16_t* Ub, bf16_t* Db, const float* prefix, int t0, int ch, int w) {
    f32x2 v[15 + R];
#pragma unroll
    for (int j = 0; j < 15 + R; ++j) { const int t = t0 - 15 + j;
        if (SAMPLE && j < 15) { v[j] = *(const f32x2*)(prefix + j * PW + ch); }
        else { const int tc = (SAMPLE || t >= 0) ? t : 0;
            unsigned wv = *(const unsigned*)(Ub + (size_t)tc * PW + ch); if (!SAMPLE && t < 0) wv = 0u; v[j].x = bf_lo(wv); v[j].y = bf_hi(wv); } }
    f32x2 s = {0.f, 0.f};
#pragma unroll
    for (int i = 1; i < 16; ++i) if (i < w) s += v[15 - i];
#pragma unroll
    for (int r = 0; r < R; ++r) { const f32x2 cur = v[15 + r]; s += cur;
        const int t = t0 + r; const float cnt = SAMPLE ? (float)w : (float)(w < t + 1 ? w : t + 1);
        const f32x2 d = s / cnt - cur;
        *(unsigned*)(Db + (size_t)t * PW + ch) = cvt_pk_bf16(d.x, d.y);
        const f32x2 sub = w == 2 ? v[15 + r - 1] : (w == 4 ? v[15 + r - 3] : (w == 8 ? v[15 + r - 7] : v[r]));
        s -= sub; }
}
DI void pool_phase(const bf16_t* U, bf16_t* D, const float* state_pool_l, int G) {
    const int tid = opaque_tid(), half = tid >> 8, ch = (tid & 255) * 2, g = ch >> 7, w = 2 << g;
    for (int item = opaque_bid(); item < 512 + 64; item += G) {
        if (item < 512) { const int b = item >> 6, t0 = (item & 63) * 32 + half * 16;
            pool_rows<16, false>(U + (size_t)b * SEQ * PW, D + (size_t)b * SEQ * PW, nullptr, t0, ch, w); }
        else { const int bs = (item - 512) * 2 + half;
            pool_rows<DS, true>(U + (size_t)(MP + bs * DS) * PW, D + (size_t)(MP + bs * DS) * PW, state_pool_l + (size_t)bs * PPAD * PW, 0, ch, w); }
    }
}

#define MFMA32(a, b, c) __builtin_amdgcn_mfma_f32_32x32x16_bf16((a), (b), (c), 0, 0, 0)
DI int crow(int reg, int h) { return (reg & 3) + 8 * (reg >> 2) + 4 * h; }
constexpr int KS_STRIDE = 72, VT_STRIDE = 264  , ATT_VT_OFF = 256 * KS_STRIDE * 2;
DI void attn_prompt_unit(LAS unsigned char* lds, const bf16_t* Q, const bf16_t* Kb, const bf16_t* Vb, bf16_t* O, const float* sinks, int unit) {
    const int tid = opaque_tid(), lane = tid & 63, wid = tid >> 6;
    const int b = unit >> 5, kvh = (unit >> 4) & 1, qblk = unit & 15;
    LAS bf16_t* Ks = (LAS bf16_t*)lds;
    LAS bf16_t* Vt = (LAS bf16_t*)(lds + ATT_VT_OFF);
    const int rowbase = b * SEQ + qblk * 128 - 128;
    __syncthreads();
#pragma unroll
    for (int i = 0; i < 4; ++i) {
        const int ch = tid + i * 512;
        { const int key = ch >> 3, c8 = ch & 7; u32x4 kv = {0u, 0u, 0u, 0u};
          if (qblk > 0 || key >= 128) kv = *(const u32x4*)(Kb + (size_t)(rowbase + key) * 128 + kvh * 64 + c8 * 8);
          *(LAS u32x4*)(Ks + key * KS_STRIDE + c8 * 8) = kv; }
        { const int key = ch & 255, c8 = ch >> 8; u32x4 vv = {0u, 0u, 0u, 0u};
          if (qblk > 0 || key >= 128) vv = *(const u32x4*)(Vb + (size_t)(rowbase + key) * 128 + kvh * 64 + c8 * 8);
          LAS bf16_t* vp = Vt + (c8 * 8) * VT_STRIDE + key;
          vp[0 * VT_STRIDE] = (bf16_t)(vv.x & 0xffffu); vp[1 * VT_STRIDE] = (bf16_t)(vv.x >> 16);
          vp[2 * VT_STRIDE] = (bf16_t)(vv.y & 0xffffu); vp[3 * VT_STRIDE] = (bf16_t)(vv.y >> 16);
          vp[4 * VT_STRIDE] = (bf16_t)(vv.z & 0xffffu); vp[5 * VT_STRIDE] = (bf16_t)(vv.z >> 16);
          vp[6 * VT_STRIDE] = (bf16_t)(vv.w & 0xffffu); vp[7 * VT_STRIDE] = (bf16_t)(vv.w >> 16); }
    }
    __syncthreads();
    const int qr = lane & 31, hl = lane >> 5;
#pragma unroll 1
    for (int it = 0; it < 2; ++it) {
        const int g = wid >> 1, sub = (wid & 1) * 2 + it, h = kvh * 4 + g, r0 = sub * 32;
        const float slope = exp2f(-(float)(h + 1)), sink = sinks[h];
        const size_t qrow = (size_t)(b * SEQ + qblk * 128 + r0 + qr);
        bf16x8 qf[4];
#pragma unroll
        for (int ks = 0; ks < 4; ++ks) qf[ks] = *(const bf16x8*)(Q + qrow * 512 + h * 64 + ks * 16 + hl * 8);
        f32x16 o[2];
#pragma unroll
        for (int e = 0; e < 16; ++e) { o[0][e] = 0.f; o[1][e] = 0.f; }
        float mrun = sink, lrun = hl == 0 ? 1.0f : 0.0f;
        const int dbase = 128 + qr - 4 * hl;
#pragma unroll 1
        for (int kt = 0; kt < 5; ++kt) {
            f32x16 st;
#pragma unroll
            for (int e = 0; e < 16; ++e) st[e] = 0.f;
#pragma unroll
            for (int ks = 0; ks < 4; ++ks) { const bf16x8 kf = *(const LAS bf16x8*)(Ks + (r0 + kt * 32 + qr) * KS_STRIDE + ks * 16 + hl * 8); st = MFMA32(kf, qf[ks], st); }
            const int dk = dbase - kt * 32, kmin = (qblk > 0) ? -1000 : 128 - r0 - kt * 32 - 4 * hl;
            float tm = -1e30f;
#pragma unroll
            for (int e = 0; e < 16; ++e) { const int ko = (e & 3) + 8 * (e >> 2); const int dist = dk - ko;
                const bool valid = ((unsigned)dist < (unsigned)WIN) && (ko >= kmin);
                const float v = valid ? st[e] - slope * (float)dist : -1e30f; st[e] = v; tm = fmaxf(tm, v); }
            tm = fmaxf(tm, shfl_xor_l(tm, 32, lane));
            const float mnew = fmaxf(mrun, tm), alpha = __expf(mrun - mnew);
            mrun = mnew; lrun *= alpha;
#pragma unroll
            for (int e = 0; e < 16; ++e) { o[0][e] *= alpha; o[1][e] *= alpha; }
            float ps = 0.f;
#pragma unroll
            for (int e = 0; e < 16; ++e) { const float p = __expf(st[e] - mnew); st[e] = p; ps += p; }
            lrun += ps;
#pragma unroll
            for (int s2 = 0; s2 < 2; ++s2) {
                u32x4 pw; pw.x = cvt_pk_bf16(st[8 * s2 + 0], st[8 * s2 + 1]); pw.y = cvt_pk_bf16(st[8 * s2 + 2], st[8 * s2 + 3]);
                pw.z = cvt_pk_bf16(st[8 * s2 + 4], st[8 * s2 + 5]); pw.w = cvt_pk_bf16(st[8 * s2 + 6], st[8 * s2 + 7]);
                const bf16x8 pf = __builtin_bit_cast(bf16x8, pw);
                const int kb = r0 + kt * 32 + 16 * s2 + 4 * hl;
#pragma unroll
                for (int dt = 0; dt < 2; ++dt) { const LAS bf16_t* vp = Vt + (dt * 32 + qr) * VT_STRIDE + kb;
                    const s16x4 lo = *(const LAS s16x4*)vp, hi = *(const LAS s16x4*)(vp + 8);
                    const bf16x8 vf = __builtin_shufflevector(lo, hi, 0, 1, 2, 3, 4, 5, 6, 7);
                    o[dt] = MFMA32(vf, pf, o[dt]); }
            }
        }
        lrun += shfl_xor_l(lrun, 32, lane);
        const float inv = 1.0f / lrun;
#pragma unroll
        for (int dt = 0; dt < 2; ++dt)
#pragma unroll
            for (int i4 = 0; i4 < 4; ++i4) { u32x2 w; w.x = cvt_pk_bf16(o[dt][4 * i4] * inv, o[dt][4 * i4 + 1] * inv); w.y = cvt_pk_bf16(o[dt][4 * i4 + 2] * inv, o[dt][4 * i4 + 3] * inv);
                *(u32x2*)(O + qrow * 512 + h * 64 + dt * 32 + 8 * i4 + 4 * hl) = w; }
    }
}
DI void attn_sample_pair(LAS unsigned char* wl, LAS unsigned char* wl_partner, int item, int part, const bf16_t* Q, const bf16_t* Kb, const bf16_t* Vb, bf16_t* O, const float* ck, const float* cv, const float* sinks) {
    const int lane = opaque_tid() & 63, b = item >> 3, h = item & 7, kvh = h >> 2;
    LAS float* qs = (LAS float*)wl;
    LAS float* sc = (LAS float*)(wl + 1024);
    LAS float* px = (LAS float*)(wl + 2304);
    const float slope = exp2f(-(float)(h + 1)), sink = sinks[h];
    const int row0 = MP + b * DS, j0 = part * 64;
    asm volatile("s_waitcnt lgkmcnt(0)" ::: "memory");
#pragma unroll
    for (int i = 0; i < DS; ++i) qs[i * 64 + lane] = bf_f(Q[(size_t)(row0 + i) * 512 + h * 64 + lane]);
    asm volatile("s_waitcnt lgkmcnt(0)" ::: "memory");
    {   const int j = j0 + lane; float a0 = 0.f, a1 = 0.f, a2 = 0.f, a3 = 0.f;
        const float* kr = ck + ((size_t)(b * WIN + j) * 2 + kvh) * 64;
#pragma unroll
        for (int d4 = 0; d4 < 16; ++d4) { const f32x4 kk = *(const f32x4*)(kr + d4 * 4);
            const f32x4 q0 = *(const LAS f32x4*)(qs + d4 * 4), q1 = *(const LAS f32x4*)(qs + 64 + d4 * 4), q2 = *(const LAS f32x4*)(qs + 128 + d4 * 4), q3 = *(const LAS f32x4*)(qs + 192 + d4 * 4);
            a0 += kk.x * q0.x + kk.y * q0.y + kk.z * q0.z + kk.w * q0.w; a1 += kk.x * q1.x + kk.y * q1.y + kk.z * q1.z + kk.w * q1.w;
            a2 += kk.x * q2.x + kk.y * q2.y + kk.z * q2.z + kk.w * q2.w; a3 += kk.x * q3.x + kk.y * q3.y + kk.z * q3.z + kk.w * q3.w; }
        const int d0 = WIN - j;
        sc[0 * 72 + lane] = (d0 + 0 >= 0 && d0 + 0 < WIN) ? a0 - slope * (float)(d0 + 0) : -1e30f;
        sc[1 * 72 + lane] = (d0 + 1 >= 0 && d0 + 1 < WIN) ? a1 - slope * (float)(d0 + 1) : -1e30f;
        sc[2 * 72 + lane] = (d0 + 2 >= 0 && d0 + 2 < WIN) ? a2 - slope * (float)(d0 + 2) : -1e30f;
        sc[3 * 72 + lane] = (d0 + 3 >= 0 && d0 + 3 < WIN) ? a3 - slope * (float)(d0 + 3) : -1e30f;
    }
    if (part == 1 && lane < DS) {
        float a0 = 0.f, a1 = 0.f, a2 = 0.f, a3 = 0.f;
        const bf16_t* kr = Kb + (size_t)(row0 + lane) * 128 + kvh * 64;
        u32x4 kw[8];
#pragma unroll
        for (int c8 = 0; c8 < 8; ++c8) kw[c8] = *(const u32x4*)(kr + c8 * 8);
#pragma unroll
        for (int c8 = 0; c8 < 8; ++c8) {
#pragma unroll
            for (int e = 0; e < 4; ++e) { const unsigned wv = kw[c8][e]; const float k0 = bf_lo(wv), k1 = bf_hi(wv); const int d = c8 * 8 + e * 2;
                a0 += k0 * qs[d] + k1 * qs[d + 1]; a1 += k0 * qs[64 + d] + k1 * qs[64 + d + 1]; a2 += k0 * qs[128 + d] + k1 * qs[128 + d + 1]; a3 += k0 * qs[192 + d] + k1 * qs[192 + d + 1]; } }
        const int d0 = -lane;
        sc[0 * 72 + 64 + lane] = (d0 + 0 >= 0) ? a0 - slope * (float)(d0 + 0) : -1e30f;
        sc[1 * 72 + 64 + lane] = (d0 + 1 >= 0) ? a1 - slope * (float)(d0 + 1) : -1e30f;
        sc[2 * 72 + 64 + lane] = (d0 + 2 >= 0) ? a2 - slope * (float)(d0 + 2) : -1e30f;
        sc[3 * 72 + 64 + lane] = (d0 + 3 >= 0) ? a3 - slope * (float)(d0 + 3) : -1e30f;
    }
    asm volatile("s_waitcnt lgkmcnt(0)" ::: "memory");
    const bool ext = (part == 1) && (lane < DS);
    float mloc[4], lloc[4];
#pragma unroll
    for (int i = 0; i < DS; ++i) {
        const float v0 = sc[i * 72 + lane], v1 = ext ? sc[i * 72 + 64 + lane] : -1e30f;
        const float mx = fmaxf(wave_max(fmaxf(v0, v1), lane), sink);
        const float p0 = __expf(v0 - mx), p1 = ext ? __expf(v1 - mx) : 0.f;
        sc[i * 72 + lane] = p0; if (ext) sc[i * 72 + 64 + lane] = p1;
        mloc[i] = mx; lloc[i] = wave_sum(p0 + p1, lane);
    }
    asm volatile("s_waitcnt lgkmcnt(0)" ::: "memory");
    float o0 = 0.f, o1 = 0.f, o2 = 0.f, o3 = 0.f;
#pragma unroll 32
    for (int jj = 0; jj < 64; ++jj) { const float vv = cv[((size_t)(b * WIN + j0 + jj) * 2 + kvh) * 64 + lane];
        o0 += sc[jj] * vv; o1 += sc[72 + jj] * vv; o2 += sc[144 + jj] * vv; o3 += sc[216 + jj] * vv; }
    if (part == 1) {
#pragma unroll
        for (int jj = 0; jj < DS; ++jj) { const float vv = bf_f(Vb[(size_t)(row0 + jj) * 128 + kvh * 64 + lane]);
            o0 += sc[64 + jj] * vv; o1 += sc[72 + 64 + jj] * vv; o2 += sc[144 + 64 + jj] * vv; o3 += sc[216 + 64 + jj] * vv; }
        if (lane < DS) { px[lane] = lane == 0 ? mloc[0] : (lane == 1 ? mloc[1] : (lane == 2 ? mloc[2] : mloc[3])); px[4 + lane] = lane == 0 ? lloc[0] : (lane == 1 ? lloc[1] : (lane == 2 ? lloc[2] : lloc[3])); }
        px[8 + lane] = o0; px[8 + 64 + lane] = o1; px[8 + 128 + lane] = o2; px[8 + 192 + lane] = o3;
    }
    __syncthreads();
    if (part == 0) {
        const LAS float* pp = (const LAS float*)(wl_partner + 2304);
        bf16_t* orow = O + (size_t)row0 * 512 + h * 64 + lane;
        const float oa[4] = {o0, o1, o2, o3};
#pragma unroll
        for (int i = 0; i < DS; ++i) { const float mb = pp[i], lb = pp[4 + i], ob = pp[8 + i * 64 + lane];
            const float mm = fmaxf(mloc[i], mb), ea = __expf(mloc[i] - mm), eb = __expf(mb - mm);
            const float den = lloc[i] * ea + lb * eb + __expf(sink - mm);
            orow[i * 512] = (bf16_t)(cvt_pk_bf16((oa[i] * ea + ob * eb) / den, 0.f) & 0xffffu); }
    }
    __syncthreads();
}

DI f32x4 small_tile(const bf16_t* A, int lda, const bf16_t* Bt, int ldb, int K, int row0, int col0, int lane) {
    const int fr = lane & 15, fq = lane >> 4;
    const bf16_t* ap = A + (size_t)(row0 + fr) * lda + fq * 8;
    const bf16_t* bp = Bt + (size_t)(col0 + fr) * ldb + fq * 8;
    f32x4 acc0 = {0.f, 0.f, 0.f, 0.f}, acc1 = {0.f, 0.f, 0.f, 0.f};
#pragma unroll 8
    for (int k = 0; k < K; k += 64) {
        const bf16x8 a0 = *(const bf16x8*)(ap + k), b0 = *(const bf16x8*)(bp + k), a1 = *(const bf16x8*)(ap + k + 32), b1 = *(const bf16x8*)(bp + k + 32);
        acc0 = __builtin_amdgcn_mfma_f32_16x16x32_bf16(b0, a0, acc0, 0, 0, 0);
        acc1 = __builtin_amdgcn_mfma_f32_16x16x32_bf16(b1, a1, acc1, 0, 0, 0);
    }
    return acc0 + acc1;
}
#define SMALL_LOOP(N_, first_) \
    const int tid_s = opaque_tid(), lane_s = tid_s & 63, w_s = tid_s >> 6, ncb_s = (N_) / 32, nblk_s = 8 * ncb_s, np_s = G - (first_); \
    if (opaque_bid() >= (first_)) for (int t_s = opaque_bid() - (first_); t_s < nblk_s; t_s += np_s)
#define SMALL_RC() const int row0 = (t_s / ncb_s) * 64 + (w_s >> 1) * 16, col0 = (t_s % ncb_s) * 32 + (w_s & 1) * 16, r = row0 + (lane_s & 15), col = col0 + 4 * (lane_s >> 4); (void)r; (void)col
DI void small_tile32(const bf16_t* A, int lda, const bf16_t* Bt, int ldb, int K, int row0, int col0, int lane, f32x4 (&acc)[2][2]) {
    const int fr = lane & 15, fq = lane >> 4;
    const bf16_t* ap = A + (size_t)(row0 + fr) * lda + fq * 8;
    const bf16_t* bp = Bt + (size_t)(col0 + fr) * ldb + fq * 8;
    const size_t a16 = (size_t)16 * lda, b16 = (size_t)16 * ldb;
#pragma unroll
    for (int i = 0; i < 2; ++i)
#pragma unroll
        for (int j = 0; j < 2; ++j) acc[i][j] = (f32x4){0.f, 0.f, 0.f, 0.f};
#pragma unroll 8
    for (int k = 0; k < K; k += 32) {
        const bf16x8 a0 = *(const bf16x8*)(ap + k), a1 = *(const bf16x8*)(ap + a16 + k), b0 = *(const bf16x8*)(bp + k), b1 = *(const bf16x8*)(bp + b16 + k);
        acc[0][0] = __builtin_amdgcn_mfma_f32_16x16x32_bf16(b0, a0, acc[0][0], 0, 0, 0);
        acc[0][1] = __builtin_amdgcn_mfma_f32_16x16x32_bf16(b1, a0, acc[0][1], 0, 0, 0);
        acc[1][0] = __builtin_amdgcn_mfma_f32_16x16x32_bf16(b0, a1, acc[1][0], 0, 0, 0);
        acc[1][1] = __builtin_amdgcn_mfma_f32_16x16x32_bf16(b1, a1, acc[1][1], 0, 0, 0);
    }
}
#define SMALL32_LOOP(N_, first_) \
    const int tid_s = opaque_tid(), lane_s = tid_s & 63, w_s = tid_s >> 6, ncb_s = (N_) / 64, nblk_s = 4 * ncb_s, np_s = G - (first_); \
    if (opaque_bid() >= (first_)) for (int t_s = opaque_bid() - (first_); t_s < nblk_s; t_s += np_s)
#define SMALL32_RC() const int row0 = (t_s / ncb_s) * 128 + (w_s >> 1) * 32, col0 = (t_s % ncb_s) * 64 + (w_s & 1) * 32
#define SMALL32_EACH() _Pragma("unroll") for (int i_s = 0; i_s < 2; ++i_s) _Pragma("unroll") for (int j_s = 0; j_s < 2; ++j_s)
#define SMALL32_ELEM() const int r = row0 + 16 * i_s + (lane_s & 15), col = col0 + 16 * j_s + 4 * (lane_s >> 4); const f32x4 v = acc_s[i_s][j_s]
DI u32x2 pack4(f32x4 v) { u32x2 w; w.x = cvt_pk_bf16(v[0], v[1]); w.y = cvt_pk_bf16(v[2], v[3]); return w; }

#define XB_TMO      128
#define XB_XCNT(j)  (256  + 64 * (j))
#define XB_XSUB(j)  (1280 + 64 * (j))
#define XB_XGEN(j)  (2304 + 64 * (j))
#define XB_TOP      3328
#define XB_TOPGEN   3392
#define XCD_BAR_WORDS 3456
#define XB_SPIN_CAP (1u << 18)

__device__ __forceinline__ unsigned xb_ld(unsigned* p)              { return __hip_atomic_load(p, __ATOMIC_RELAXED, __HIP_MEMORY_SCOPE_AGENT); }
__device__ __forceinline__ unsigned xb_add(unsigned* p, unsigned v) { return __hip_atomic_fetch_add(p, v, __ATOMIC_RELAXED, __HIP_MEMORY_SCOPE_AGENT); }
__device__ __forceinline__ unsigned xb_xcc_id() { return (unsigned)__builtin_amdgcn_s_getreg((3 << 11) | 20) & 0xFu; }
#define XB_SPIN(cond, bar) do { unsigned _sp = 0; while (cond) { __builtin_amdgcn_s_sleep(1); \
    if ((++_sp & 255u) == 0u) { if (xb_ld(&(bar)[XB_TMO])) break; if (_sp > XB_SPIN_CAP) { atomicAdd(&(bar)[XB_TMO], 1u); break; } } } } while (0)

struct XcdBarrier {
    unsigned* bar; unsigned x;
    volatile LAS unsigned* st;
};

__device__ __forceinline__ XcdBarrier xcd_barrier_post(unsigned* bar, volatile LAS unsigned* st) {
    XcdBarrier b; b.bar = bar; b.x = xb_xcc_id(); b.st = st;
    if (threadIdx.x == 0) (void)xb_add(&bar[XB_XCNT(b.x)], 1u);
    return b;
}
__device__ __forceinline__ void xcd_barrier_complete(unsigned* bar, unsigned x, unsigned& nloc, unsigned& nx) {
    const unsigned G = gridDim.x * gridDim.y * gridDim.z;
    unsigned sum, cnt, mine, sp = 0u;
    for (;;) {
        sum = 0u; cnt = 0u; mine = 0u;
#pragma unroll
        for (unsigned j = 0; j < 16; ++j) { const unsigned c = xb_ld(&bar[XB_XCNT(j)]); sum += c; cnt += (c > 0u) ? 1u : 0u; mine = (j == x) ? c : mine; }
        if (sum == G) break;
        __builtin_amdgcn_s_sleep(1);
        if ((++sp & 255u) == 0u) { if (xb_ld(&bar[XB_TMO])) break; if (sp > XB_SPIN_CAP) { atomicAdd(&bar[XB_TMO], 1u); break; } }
    }
    nloc = mine > 0u ? mine : 1u; nx = cnt > 0u ? cnt : 1u;
}

__device__ __forceinline__ void xcd_barrier(const XcdBarrier& b) {
    asm volatile("s_waitcnt vmcnt(0)" ::: "memory");
    __syncthreads();
    if (threadIdx.x == 0) {
        unsigned* bar = b.bar; asm volatile("" : "+s"(bar));
        __builtin_amdgcn_s_waitcnt(0);
        unsigned nloc = b.st[0], nx = b.st[1];
        if (nloc == 0u) { xcd_barrier_complete(bar, b.x, nloc, nx); b.st[0] = nloc; b.st[1] = nx; }
        const unsigned old = xb_add(&bar[XB_XSUB(b.x)], 1u);
        const unsigned gen = old / nloc;
        if (old + 1u == (gen + 1u) * nloc) {
            __builtin_amdgcn_fence(__ATOMIC_RELEASE, "agent");
            asm volatile("s_waitcnt vmcnt(0)" ::: "memory");
            const unsigned og = xb_add(&bar[XB_TOP], 1u);
            const unsigned tg = og / nx;
            if (og + 1u == (tg + 1u) * nx) xb_add(&bar[XB_TOPGEN], 1u);
            else XB_SPIN(xb_ld(&bar[XB_TOPGEN]) == tg, bar);
            __builtin_amdgcn_fence(__ATOMIC_ACQUIRE, "agent");
            xb_add(&bar[XB_XGEN(b.x)], 1u);
            asm volatile("s_waitcnt vmcnt(0)" ::: "memory");
        } else {
            XB_SPIN(xb_ld(&bar[XB_XGEN(b.x)]) == gen, bar);
            __builtin_amdgcn_fence(__ATOMIC_ACQUIRE, "agent");
            asm volatile("s_waitcnt vmcnt(0)" ::: "memory");
        }
    }
    __syncthreads();
}


__global__ void __launch_bounds__(512, 2) fwd_kernel(Args a) {
    extern __shared__ __attribute__((aligned(16))) unsigned char lds_raw[];
    LAS unsigned char* lds = (LAS unsigned char*)lds_raw;
    cg::grid_group grid = cg::this_grid();
    volatile LAS unsigned* xb_st = (volatile LAS unsigned*)(lds + LDS_BYTES - 64);
    if (threadIdx.x == 0) { xb_st[0] = 0u; xb_st[1] = 0u; }
    __syncthreads();
    XcdBarrier xbar = xcd_barrier_post((unsigned*)a.ws + 4096, xb_st);
    const int G = gridDim.x, lo = a.ph_lo, hi = a.ph_hi;
typedef __attribute__((address_space(1))) unsigned char gchar_t; typedef __attribute__((address_space(1))) float gfloat_t;
#define PHASE_BEGIN gchar_t* wsg_ = (gchar_t*)a.ws; gfloat_t* outg_ = (gfloat_t*)a.out; asm volatile("" : "+s"(wsg_), "+s"(outg_)); unsigned char* ws_ = (unsigned char*)wsg_; float* out_ = (float*)outg_;
#define X1 (out_ + OFF_Y)
#define mod ((float*)(ws_ + WS_MOD))
#define H ((bf16_t*)(ws_ + WS_H))
#define Ub ((bf16_t*)(ws_ + WS_U))
#define Qb ((bf16_t*)(ws_ + WS_Q))
#define Kb ((bf16_t*)(ws_ + WS_K))
#define Vb ((bf16_t*)(ws_ + WS_V))
#define GA ((bf16_t*)(ws_ + WS_GA))
#define GB ((bf16_t*)(ws_ + WS_GB))
#define Db ((bf16_t*)(ws_ + WS_D))
#define Ob ((bf16_t*)(ws_ + WS_O))
#define FF ((bf16_t*)(ws_ + WS_FF))
#define PB ((float*)(ws_ + WS_PB))
#define wl (ws_ + WS_W + (size_t)l * WS_WL)
#define modl (mod + l * NMOD)
#define xp (l == 0 ? a.in[0] : (const float*)X1)
#define xs (l == 0 ? a.in[1] : (const float*)(X1 + (size_t)MP * DM))
#ifndef PHASE_MASK
#define PHASE_MASK 0xffff
#endif
#ifndef MK_REPEAT_MASK
#define MK_REPEAT_MASK 0
#endif
#ifndef MK_MIX_SUB
#define MK_MIX_SUB 7
#endif
#ifndef MK_PROBE_OUT
#define MK_PROBE_OUT 0
#endif
#ifndef MK_PROBE_DOWN
#define MK_PROBE_DOWN 0
#endif
#ifndef MK_EXTRA_SYNCS
#define MK_EXTRA_SYNCS 0
#endif
#define REP(id) for (int rep_ = 0; rep_ < 1 + ((((MK_REPEAT_MASK) >> (id)) & 1)); ++rep_)
#define IN(k, id) ((((PHASE_MASK) >> (id)) & 1) && lo <= (k) && (k) < hi)
#define SEAM(k) do { if (lo <= (k) && (k) + 1 < hi) xcd_barrier(xbar); } while (0)

    if (a.ph_hi < 0) grid.sync();
    if (IN(0, 0)) { PHASE_BEGIN REP(0) prologue(a, lds, G); SEAM(0); for (int e_ = 0; e_ < MK_EXTRA_SYNCS; ++e_) xcd_barrier(xbar); }
    if (IN(1, 1)) { PHASE_BEGIN REP(1) {
        pg8::Gemm g{(const bf16_t*)(ws_ + WS_SC), (const bf16_t*)(ws_ + WS_WADA), 256, 2 * NMOD, DM, DM, DM};
        pg8::StaticOrder S; S.init(256, 2 * NMOD, G, opaque_bid());
        EpiAda E{mod, a.in[8]};
        pg8::gemm_phase<EpiAda, pg8::StaticOrder, true>(lds, g, S, E);
        }
        SEAM(1);
    }
#pragma unroll 1
    for (int l = 0; l < DEPTH; ++l) {
        const int pb = 2 + 8 * l;
        if (IN(pb + 0, 2)) { PHASE_BEGIN REP(2) norm_phase(xp, xs, a.in[9] + l * DM, modl, 0 * DM, 1 * DM, H, G, l == 0 ? nullptr : PB, mod + (l - 1) * NMOD + 5 * DM, X1 + (size_t)MP * DM); SEAM(pb + 0); }
        if (IN(pb + 1, 3)) { PHASE_BEGIN REP(3) {
            pg8::Gemm g{H, (const bf16_t*)(wl + W_IN), MP, NIN, DM, DM, DM};
            pg8::StaticOrder S; S.init(MP, NIN, G, opaque_bid());
            EpiIn E{Ub, Qb, Kb, Vb, GA, GB, a.out, l};
            pg8::gemm_phase<EpiIn, pg8::StaticOrder, true>(lds, g, S, E);
            {
                const int first = (G == 256) ? 64 : 0;
                SMALL32_LOOP(NIN, first) { SMALL32_RC(); f32x4 acc_s[2][2];
                    small_tile32(H + (size_t)MP * DM, DM, (const bf16_t*)(wl + W_IN), DM, DM, row0, col0, lane_s, acc_s);
                    SMALL32_EACH() { SMALL32_ELEM();
                    const size_t grow = (size_t)(MP + r);
                    if (col < 512) { *(u32x2*)(Ub + grow * 512 + col) = pack4(v);
                        *(f32x4*)(a.out + OFF_PS + ((l * DB + (r >> 2)) * PPAD + (PPAD - DS) + (r & 3)) * PW + col) = v; }
                    else if (col < 1024) { *(u32x2*)(Qb + grow * 512 + (col - 512)) = pack4(v * 0.125f); }
                    else if (col < 1152) { *(u32x2*)(Kb + grow * 128 + (col - 1024)) = pack4(v);
                        *(f32x4*)(a.out + OFF_KS + ((l * DB + (r >> 2)) * WIN + (WIN - DS) + (r & 3)) * 128 + (col - 1024)) = v; }
                    else if (col < 1280) { *(u32x2*)(Vb + grow * 128 + (col - 1152)) = pack4(v);
                        *(f32x4*)(a.out + OFF_VS + ((l * DB + (r >> 2)) * WIN + (WIN - DS) + (r & 3)) * 128 + (col - 1152)) = v; }
                    else { f32x4 sg; sg[0] = sigmoidf_(v[0]); sg[1] = sigmoidf_(v[1]); sg[2] = sigmoidf_(v[2]); sg[3] = sigmoidf_(v[3]);
                        bf16_t* dst = col < 2304 ? GA + (col - 1280) : GB + (col - 2304);
                        *(u32x2*)(dst + grow * 1024) = pack4(sg); } }
                }
            } }
            SEAM(pb + 1);
        }
        if (IN(pb + 2, 4)) { PHASE_BEGIN REP(4) {
            const float* sinks = a.in[13] + l * 8;
            rolling_copy(a, l, G);
            const bool last_rep_ = (rep_ == (((MK_REPEAT_MASK) >> 4) & 1));
            if (last_rep_ || (MK_MIX_SUB & 1))
            for (int u = opaque_bid(); u < 256; u += G) attn_prompt_unit(lds, Qb, Kb, Vb, Ob, sinks, u);
            if (last_rep_ || (MK_MIX_SUB & 2))
            { const int wave = opaque_tid() >> 6;
              for (int it = opaque_bid() * 4 + (wave & 3); it < DB * 8; it += G * 4)
                  attn_sample_pair(lds + 73728 + wave * 4096, lds + 73728 + (wave ^ 4) * 4096, it, wave >> 2, Qb, Kb, Vb, Ob, a.in[2] + (size_t)l * DB * WIN * 128, a.in[3] + (size_t)l * DB * WIN * 128, sinks); }
            if (last_rep_ || (MK_MIX_SUB & 4))
            pool_phase(Ub, Db, a.in[4] + (size_t)l * DB * PPAD * PW, G);
            }
            SEAM(pb + 2);
        }
        if (IN(pb + 3, 5)) { PHASE_BEGIN REP(5) {
            { pg8::Gemm g{Db, (const bf16_t*)(wl + W_PA), MP, DM, PW, PW, PW};
              pg8::StaticOrder S; S.init(MP, DM, G, opaque_bid());
              EpiMix<0> E{GA, H};
              pg8::gemm_phase<EpiMix<0>, pg8::StaticOrder, true>(lds, g, S, E); }
#ifndef MK_SKIP_MIX2
            { pg8::Gemm g{Ob, (const bf16_t*)(wl + W_B), MP, DM, PW, PW, PW};
              pg8::StaticOrder S; S.init(MP, DM, G, opaque_bid());
              EpiMix<1> E{GB, H};
              pg8::gemm_phase<EpiMix<1>, pg8::StaticOrder, true>(lds, g, S, E); }
#endif
            {   SMALL_LOOP(DM, 0) { SMALL_RC();
                    const f32x4 va = small_tile(Db + (size_t)MP * PW, PW, (const bf16_t*)(wl + W_PA), PW, PW, row0, col0, lane_s);
                    const f32x4 vb = small_tile(Ob + (size_t)MP * PW, PW, (const bf16_t*)(wl + W_B), PW, PW, row0, col0, lane_s);
                    const size_t off = (size_t)(MP + r) * 1024 + col;
                    const u32x2 ga = *(const u32x2*)(GA + off), gb = *(const u32x2*)(GB + off);
                    f32x4 mg; mg[0] = bf_lo(ga.x) * va[0] + bf_lo(gb.x) * vb[0]; mg[1] = bf_hi(ga.x) * va[1] + bf_hi(gb.x) * vb[1];
                    mg[2] = bf_lo(ga.y) * va[2] + bf_lo(gb.y) * vb[2]; mg[3] = bf_hi(ga.y) * va[3] + bf_hi(gb.y) * vb[3];
                    *(u32x2*)(H + off) = pack4(mg); }
            } }
            SEAM(pb + 3);
        }
        if (IN(pb + 4, 6)) { PHASE_BEGIN for (int rp_ = 0; rp_ < 1 + MK_PROBE_OUT; ++rp_) { const float gs = (rp_ == MK_PROBE_OUT) ? 1.f : 0.f;
            pg8::Gemm g{H, (const bf16_t*)(wl + W_OUT), MP, DM, DM, DM, DM};
            pg8::StaticOrder S; S.init(MP, DM, G, opaque_bid());
            EpiRes E{xp, xs, modl + 2 * DM, X1, gs};
            pg8::gemm_phase<EpiRes, pg8::StaticOrder, true>(lds, g, S, E);
            {
                int kc = 128; asm volatile("" : "+s"(kc));
                pg8::Gemm g2{H, (const bf16_t*)(wl + W_OUT), M, DM, kc, DM, DM};
                pg8::SplitKOrder S2{G, opaque_bid(), 8, kc};
                EpiPartial E2{PB, kc};
                pg8::gemm_phase<EpiPartial, pg8::SplitKOrder, true>(lds, g2, S2, E2);
            } }
            SEAM(pb + 4);
        }
        if (IN(pb + 5, 7)) { PHASE_BEGIN REP(7) norm_phase(X1, xs, a.in[17] + l * DM, modl, 3 * DM, 4 * DM, H, G, PB, modl + 2 * DM, X1 + (size_t)MP * DM); SEAM(pb + 5); }
        if (IN(pb + 6, 8)) { PHASE_BEGIN REP(8) {
            pg8::Gemm g{H, (const bf16_t*)(wl + W_UP), MP, DFF, DM, DM, DM};
            pg8::StaticOrder S; S.init(MP, DFF, G, opaque_bid());
            EpiUp E{FF};
            pg8::gemm_phase<EpiUp, pg8::StaticOrder, true>(lds, g, S, E);
            {   SMALL32_LOOP(DFF, 0) { SMALL32_RC(); f32x4 acc_s[2][2];
                    small_tile32(H + (size_t)MP * DM, DM, (const bf16_t*)(wl + W_UP), DM, DM, row0, col0, lane_s, acc_s);
                    SMALL32_EACH() { SMALL32_ELEM();
                        f32x4 q; q[0] = fmaxf(v[0], 0.f); q[1] = fmaxf(v[1], 0.f); q[2] = fmaxf(v[2], 0.f); q[3] = fmaxf(v[3], 0.f);
                        *(u32x2*)(FF + (size_t)(MP + r) * DFF + col) = pack4(q * q); } }
            } }
            SEAM(pb + 6);
        }
        if (IN(pb + 7, 9)) { PHASE_BEGIN for (int rp_ = 0; rp_ < 1 + MK_PROBE_DOWN; ++rp_) { const float gs = (rp_ == MK_PROBE_DOWN) ? 1.f : 0.f;
#if MK_PROBE_DOWN != 2
            pg8::Gemm g{FF, (const bf16_t*)(wl + W_DOWN), MP, DM, DFF, DFF, DFF};
            pg8::StaticOrder S; S.init(MP, DM, G, opaque_bid());
            EpiRes E{X1, X1 + (size_t)MP * DM, modl + 5 * DM, X1, gs};
            pg8::gemm_phase<EpiRes, pg8::StaticOrder, true>(lds, g, S, E);
#endif
            {   pg8::Gemm g2{FF, (const bf16_t*)(wl + W_DOWN), M, DM, 512, DFF, DFF};
                pg8::SplitKOrder S2{G, opaque_bid(), 8, 512};
                EpiPartial E2{PB, 512};
                pg8::gemm_phase<EpiPartial, pg8::SplitKOrder, true>(lds, g2, S2, E2);
            } }
            SEAM(pb + 7);
        }
    }
    if (IN(18, 10)) { PHASE_BEGIN final_norm_phase(X1, a.in[20], G, PB, mod + (DEPTH - 1) * NMOD + 5 * DM); }
#ifdef MK_DUMP
    { grid.sync();
      const int gt = opaque_bid() * 512 + threadIdx.x, NGT = G * 512;
#if MK_DUMP == 6
      for (int i = gt; i < M * 1024; i += NGT) X1[i] = bf_f(H[i]);
#else
      for (int i = gt; i < M * 512; i += NGT) { const int r = i >> 9, c = i & 511; X1[r * 1024 + c] = bf_f(Db[i]); X1[r * 1024 + 512 + c] = bf_f(Ob[i]); }
#endif
    }
#endif
#undef IN
#undef SEAM
#undef X1
#undef mod
#undef H
#undef Ub
#undef Qb
#undef Kb
#undef Vb
#undef GA
#undef GB
#undef Db
#undef Ob
#undef FF
#undef PB
#undef wl
#undef modl
#undef xp
#undef xs
}

#ifndef MK_PH_HI
#define MK_PH_HI 19
#endif
constexpr int N_PHASES = MK_PH_HI;

extern "C" void kernel_launch(void* const* d_in, const int* in_sizes, int n_in, void* d_out, int out_size, void* d_ws, size_t ws_size, hipStream_t stream) {
    static int grid = 0;
    if (grid == 0) {
        if (n_in != 21 || out_size != OUT_TOTAL || ws_size < WS_END) { fprintf(stderr, "kernel_launch: unexpected shapes: n_in %d out %d ws %zu\n", n_in, out_size, ws_size); grid = -1; return; }
        int dev = 0, cus = 0, per_cu = 0;
        hipGetDevice(&dev);
        hipDeviceGetAttribute(&cus, hipDeviceAttributeMultiprocessorCount, dev);
        if (hipFuncSetAttribute((const void*)fwd_kernel, hipFuncAttributeMaxDynamicSharedMemorySize, LDS_BYTES) != hipSuccess) { fprintf(stderr, "kernel_launch: hipFuncSetAttribute failed\n"); grid = -1; return; }
        if (hipOccupancyMaxActiveBlocksPerMultiprocessor(&per_cu, (const void*)fwd_kernel, 512, LDS_BYTES) != hipSuccess || per_cu < 1) { fprintf(stderr, "kernel_launch: occupancy query failed (%d)\n", per_cu); (void)hipGetLastError(); per_cu = 1; }
        if (per_cu > 1) per_cu = 1;
        grid = cus * per_cu;
        fprintf(stderr, "kernel_launch: grid %d (cus %d)\n", grid, cus);
    }
    if (grid < 0) return;
    if (hipMemsetAsync(d_ws, 0, 65536, stream) != hipSuccess) { fprintf(stderr, "kernel_launch: memset failed\n"); return; }
    Args a{};
    for (int i = 0; i < 21; ++i) a.in[i] = (const float*)d_in[i];
    a.out = (float*)d_out; a.ws = (unsigned char*)d_ws;
#if MK_PER_PHASE
    for (int p = 0; p < N_PHASES; ++p) {
        a.ph_lo = p; a.ph_hi = p + 1;
        hipLaunchKernelGGL(fwd_kernel, dim3(grid), dim3(512), LDS_BYTES, stream, a);
    }
#else
    a.ph_lo = 0; a.ph_hi = N_PHASES;
    void* args[] = {&a};
    hipError_t e = hipLaunchCooperativeKernel((const void*)fwd_kernel, dim3(grid), dim3(512), args, LDS_BYTES, stream);
    if (e != hipSuccess) fprintf(stderr, "kernel_launch: cooperative launch failed: %s (grid %d)\n", hipGetErrorString(e), grid);
#endif
}
```
